# Optimizing an MI355X kernel written in HIP

```python
import math
import jax, jax.numpy as jnp
from jax import lax
import numpy as np

D_MODEL = 1024
BATCH = 8
SEQ = 4096
DEPTH = 4

N_MEM = 256
SSM_WIDTH = D_MODEL // 2
SSM_GROUP = 16
SSM_GROUPS = SSM_WIDTH // SSM_GROUP
SSM_STATE = 64
DT_MIN = 1e-3
DT_MAX = 1e-1
POOL_WIDTH = D_MODEL // 2
POOL_WINDOWS = (2, 4, 8, 16)
POOL_GROUP = POOL_WIDTH // len(POOL_WINDOWS)
IN_COLS = SSM_WIDTH + POOL_WIDTH + 2 * D_MODEL
N_XHEADS = 4
XHEAD_DIM = D_MODEL // N_XHEADS
D_FF_DENSE = ((8 * D_MODEL // 3 + 127) // 128) * 128
N_EXPERTS = 8
TOP_K = 2
D_FF_EXPERT = 7 * D_MODEL // 2
N_DENSE = (DEPTH + 1) // 2
N_MOE = DEPTH // 2
ALPHA = (2 * DEPTH) ** 0.25
BETA = (8 * DEPTH) ** -0.25
LN_EPS = 1e-5

kernel_name = 'hybrid_s5_pool_xattn_moe_deepnorm'


def layer_norm(x, g, b):
    xf = x.astype(jnp.float32)
    mu = jnp.mean(xf, axis=-1, keepdims=True)
    xc = xf - mu
    var = jnp.mean(xc * xc, axis=-1, keepdims=True)
    return (xc * lax.rsqrt(var + LN_EPS)).astype(x.dtype) * g + b


def _complex_affine_combine(earlier, later):
    a1r, a1i, b1r, b1i = earlier
    a2r, a2i, b2r, b2i = later
    ar = a2r * a1r - a2i * a1i
    ai = a2r * a1i + a2i * a1r
    br = a2r * b1r - a2i * b1i + b2r
    bi = a2r * b1i + a2i * b1r + b2i
    return (ar, ai, br, bi)


def ssm_branch(u, a_re, a_im, log_dt, b_re, b_im, c_re, c_im, d, w_glu, b_glu):
    dtype = u.dtype
    bsz, seq, _ = u.shape
    f32 = jnp.float32
    uf = u.astype(f32)
    ug = uf.reshape(bsz, seq, SSM_GROUPS, SSM_GROUP)
    a_re, a_im = a_re.astype(f32), a_im.astype(f32)
    dt = jnp.exp(log_dt.astype(f32))[:, None]
    mag = jnp.exp(a_re * dt)
    lam_re = mag * jnp.cos(a_im * dt)
    lam_im = mag * jnp.sin(a_im * dt)
    den = a_re * a_re + a_im * a_im
    num_re = lam_re - 1.0
    f_re = (num_re * a_re + lam_im * a_im) / den
    f_im = (lam_im * a_re - num_re * a_im) / den
    b_re, b_im = b_re.astype(f32), b_im.astype(f32)
    bb_re = f_re[..., None] * b_re - f_im[..., None] * b_im
    bb_im = f_re[..., None] * b_im + f_im[..., None] * b_re
    bu_re = jnp.einsum('bsgc,gpc->bsgp', ug, bb_re)
    bu_im = jnp.einsum('bsgc,gpc->bsgp', ug, bb_im)
    a_seq_re = jnp.broadcast_to(lam_re, (1, seq, SSM_GROUPS, SSM_STATE))
    a_seq_im = jnp.broadcast_to(lam_im, (1, seq, SSM_GROUPS, SSM_STATE))
    _, _, h_re, h_im = lax.associative_scan(
        _complex_affine_combine, (a_seq_re, a_seq_im, bu_re, bu_im), axis=1)
    y = (jnp.einsum('bsgp,gcp->bsgc', h_re, c_re.astype(f32))
         - jnp.einsum('bsgp,gcp->bsgc', h_im, c_im.astype(f32)))
    y = y.reshape(bsz, seq, SSM_WIDTH) + d.astype(f32) * uf
    y = jax.nn.gelu(y)
    y = y * jax.nn.sigmoid(y @ w_glu.astype(f32) + b_glu.astype(f32))
    return y.astype(dtype)


def pool_branch(u, pool_w, pool_scale):
    dtype = u.dtype
    bsz, seq, _ = u.shape
    uf = u.astype(jnp.float32)
    cs = jnp.cumsum(uf, axis=1)
    pos = jnp.arange(1, seq + 1, dtype=jnp.float32)
    outs = []
    for gi, win in enumerate(POOL_WINDOWS):
        sl = slice(gi * POOL_GROUP, (gi + 1) * POOL_GROUP)
        c = cs[..., sl]
        prev = jnp.pad(c[:, :-win], ((0, 0), (win, 0), (0, 0)))
        mean = (c - prev) / jnp.minimum(pos, float(win))[None, :, None]
        outs.append(mean - uf[..., sl])
    y = jnp.stack(outs, axis=2)
    y = jnp.einsum('bsgc,gcd->bsgd', y, pool_w.astype(jnp.float32))
    y = y.reshape(bsz, seq, POOL_WIDTH) * pool_scale.astype(jnp.float32)
    return y.astype(dtype)


def hybrid_mixer(x, w_in, a_re, a_im, log_dt, b_re, b_im, c_re, c_im, d,
                 w_glu, b_glu, w_ssm_up, pool_w, pool_scale, w_pool_up, w_out):
    proj = x @ w_in
    u_ssm = proj[..., :SSM_WIDTH]
    u_pool = proj[..., SSM_WIDTH:SSM_WIDTH + POOL_WIDTH]
    gates = jax.nn.sigmoid(proj[..., SSM_WIDTH + POOL_WIDTH:])
    g_ssm, g_pool = gates[..., :D_MODEL], gates[..., D_MODEL:]
    y_ssm = ssm_branch(u_ssm, a_re, a_im, log_dt, b_re, b_im, c_re, c_im,
                       d, w_glu, b_glu) @ w_ssm_up
    y_pool = pool_branch(u_pool, pool_w, pool_scale) @ w_pool_up
    return (g_ssm * y_ssm + g_pool * y_pool) @ w_out


def cross_attention(x, mem, wq, wk, wv, wo):
    bsz, seq, _ = x.shape
    q = (x @ wq).reshape(bsz, seq, N_XHEADS, XHEAD_DIM)
    k = (mem @ wk).reshape(bsz, -1, N_XHEADS, XHEAD_DIM)
    v = (mem @ wv).reshape(bsz, -1, N_XHEADS, XHEAD_DIM)
    scores = jnp.einsum('bshd,bmhd->bhsm', q, k) * (XHEAD_DIM ** -0.5)
    probs = jax.nn.softmax(scores.astype(jnp.float32), axis=-1).astype(v.dtype)
    out = jnp.einsum('bhsm,bmhd->bshd', probs, v).reshape(bsz, seq, D_MODEL)
    return out @ wo


def swiglu_ffn(x, w1, w3, w2):
    return (jax.nn.silu(x @ w1) * (x @ w3)) @ w2


def moe_ffn(x, router, w1, w3, w2):
    bsz, seq, d = x.shape
    xt = x.reshape(-1, d)
    logits = (xt @ router).astype(jnp.float32)
    top_val, top_idx = lax.top_k(logits, TOP_K)
    top_w = jax.nn.softmax(top_val, axis=-1)
    gates = jnp.sum(jax.nn.one_hot(top_idx, N_EXPERTS, dtype=jnp.float32)
                    * top_w[..., None], axis=1).astype(x.dtype)
    out = jnp.zeros_like(xt)
    for e in range(N_EXPERTS):
        out = out + gates[:, e:e + 1] * swiglu_ffn(xt, w1[e], w3[e], w2[e])
    return out.reshape(bsz, seq, d)


def setup_inputs(seed: int = 0) -> dict:
    key = jax.random.key(seed)
    ks = jax.random.split(key, 40)
    f32 = jnp.float32
    L, G, P, C, D = DEPTH, SSM_GROUPS, SSM_STATE, SSM_GROUP, D_MODEL

    def nrm(i, shape, scale):
        return scale * jax.random.normal(ks[i], shape, f32)

    a_im_init = jnp.broadcast_to(math.pi * jnp.arange(P, dtype=f32), (L, G, P))
    return {
        'x': nrm(0, (BATCH, SEQ, D), 1.0),
        'mem': nrm(1, (BATCH, N_MEM, D), 1.0),
        'ln_mix_g': 1.0 + nrm(2, (L, D), 0.02),
        'ln_mix_b': nrm(3, (L, D), 0.02),
        'w_in': nrm(4, (L, D, IN_COLS), D ** -0.5),
        'ssm_a_re': -0.5 + nrm(5, (L, G, P), 0.01),
        'ssm_a_im': a_im_init + nrm(6, (L, G, P), 0.01),
        'ssm_log_dt': jax.random.uniform(ks[7], (L, G), f32, math.log(DT_MIN), math.log(DT_MAX)),
        'ssm_b_re': nrm(8, (L, G, P, C), (2 * C) ** -0.5),
        'ssm_b_im': nrm(9, (L, G, P, C), (2 * C) ** -0.5),
        'ssm_c_re': nrm(10, (L, G, C, P), (2 * P) ** -0.5),
        'ssm_c_im': nrm(11, (L, G, C, P), (2 * P) ** -0.5),
        'ssm_d': nrm(12, (L, SSM_WIDTH), 1.0),
        'ssm_w_glu': nrm(13, (L, SSM_WIDTH, SSM_WIDTH), SSM_WIDTH ** -0.5),
        'ssm_b_glu': nrm(14, (L, SSM_WIDTH), 0.01),
        'w_ssm_up': nrm(15, (L, SSM_WIDTH, D), BETA * SSM_WIDTH ** -0.5),
        'pool_w': nrm(16, (L, len(POOL_WINDOWS), POOL_GROUP, POOL_GROUP), POOL_GROUP ** -0.5),
        'pool_scale': 1.0 + nrm(17, (L, POOL_WIDTH), 0.02),
        'w_pool_up': nrm(18, (L, POOL_WIDTH, D), BETA * POOL_WIDTH ** -0.5),
        'w_out': nrm(19, (L, D, D), BETA * D ** -0.5),
        'ln_xa_g': 1.0 + nrm(20, (L, D), 0.02),
        'ln_xa_b': nrm(21, (L, D), 0.02),
        'xa_wq': nrm(22, (L, D, D), D ** -0.5),
        'xa_wk': nrm(23, (L, D, D), D ** -0.5),
        'xa_wv': nrm(24, (L, D, D), BETA * D ** -0.5),
        'xa_wo': nrm(25, (L, D, D), BETA * D ** -0.5),
        'ln_ffn_g': 1.0 + nrm(26, (L, D), 0.02),
        'ln_ffn_b': nrm(27, (L, D), 0.02),
        'ffn_w1': nrm(28, (N_DENSE, D, D_FF_DENSE), BETA * D ** -0.5),
        'ffn_w3': nrm(29, (N_DENSE, D, D_FF_DENSE), BETA * D ** -0.5),
        'ffn_w2': nrm(30, (N_DENSE, D_FF_DENSE, D), BETA * D_FF_DENSE ** -0.5),
        'moe_router': nrm(31, (N_MOE, D, N_EXPERTS), D ** -0.5),
        'moe_w1': nrm(32, (N_MOE, N_EXPERTS, D, D_FF_EXPERT), BETA * D ** -0.5),
        'moe_w3': nrm(33, (N_MOE, N_EXPERTS, D, D_FF_EXPERT), BETA * D ** -0.5),
        'moe_w2': nrm(34, (N_MOE, N_EXPERTS, D_FF_EXPERT, D), BETA * D_FF_EXPERT ** -0.5),
    }


def reference(x, mem, ln_mix_g, ln_mix_b, w_in, ssm_a_re, ssm_a_im, ssm_log_dt,
              ssm_b_re, ssm_b_im, ssm_c_re, ssm_c_im, ssm_d, ssm_w_glu, ssm_b_glu,
              w_ssm_up, pool_w, pool_scale, w_pool_up, w_out, ln_xa_g, ln_xa_b,
              xa_wq, xa_wk, xa_wv, xa_wo, ln_ffn_g, ln_ffn_b, ffn_w1, ffn_w3, ffn_w2,
              moe_router, moe_w1, moe_w3, moe_w2):
    for l in range(DEPTH):
        y = hybrid_mixer(x, w_in[l], ssm_a_re[l], ssm_a_im[l], ssm_log_dt[l],
                         ssm_b_re[l], ssm_b_im[l], ssm_c_re[l], ssm_c_im[l], ssm_d[l],
                         ssm_w_glu[l], ssm_b_glu[l], w_ssm_up[l], pool_w[l],
                         pool_scale[l], w_pool_up[l], w_out[l])
        x = layer_norm(ALPHA * x + y, ln_mix_g[l], ln_mix_b[l])
        y = cross_attention(x, mem, xa_wq[l], xa_wk[l], xa_wv[l], xa_wo[l])
        x = layer_norm(ALPHA * x + y, ln_xa_g[l], ln_xa_b[l])
        if l % 2 == 0:
            y = swiglu_ffn(x, ffn_w1[l // 2], ffn_w3[l // 2], ffn_w2[l // 2])
        else:
            y = moe_ffn(x, moe_router[l // 2], moe_w1[l // 2], moe_w3[l // 2], moe_w2[l // 2])
        x = layer_norm(ALPHA * x + y, ln_ffn_g[l], ln_ffn_b[l])
    return x
```

```cpp
#include <hip/hip_runtime.h>
#include <cstdio>
#include <cstdint>

#ifndef MK_PER_PHASE
#define MK_PER_PHASE 1
#endif
#ifndef MK_PMAX
#define MK_PMAX 1000
#endif
#ifndef MK_DIRECT
#define MK_DIRECT 0
#endif

#define LAS __attribute__((address_space(3)))
typedef unsigned short bf16_t;
typedef short bf16x8 __attribute__((ext_vector_type(8)));
typedef float f32x4 __attribute__((ext_vector_type(4)));
typedef float f32x2 __attribute__((ext_vector_type(2)));
typedef unsigned u32x4 __attribute__((ext_vector_type(4)));
typedef unsigned u32x2 __attribute__((ext_vector_type(2)));
typedef __attribute__((address_space(1))) unsigned char GU8;
typedef __attribute__((address_space(1))) float GF32;

constexpr int NB = 8, SEQ = 4096, D = 1024, T = NB * SEQ, DEPTH = 4;
constexpr int NMEM = 256, MROWS = NB * NMEM;
constexpr int SSMW = 512, NG = 32, GC = 16, NP = 64;
constexpr int INC = 3072;
constexpr int NH = 4, HD = 256;
constexpr int FFD = 2816, NE = 8, FFE = 3584;
constexpr int CH = 16;
constexpr int NCH = SEQ / CH;
constexpr int CROWS = T / CH;
constexpr int UCLD = 384;
constexpr float ALPHA = 1.6817928305074290f;
constexpr float LN_EPS = 1e-5f;
constexpr int MOE_ROWS = 2 * T + NE * 256;

constexpr size_t MiB = 1u << 20;
constexpr size_t WS_CTL = 0, CTL_ZERO_BYTES = 1 * MiB;
constexpr size_t WS_XB = 1 * MiB;
constexpr size_t WS_WL = WS_XB + 64 * MiB;
constexpr size_t  WL_WIN = 0, WL_WGLU = 6 * MiB, WL_WPBD = WL_WGLU + MiB / 2, WL_WSUP = 7 * MiB, WL_WPUP = 8 * MiB, WL_WOUT = 9 * MiB,
                  WL_WQ = 11 * MiB, WL_WO = 13 * MiB, WL_BT1 = 15 * MiB, WL_BT2 = 19 * MiB, WL_END = 25 * MiB;
constexpr size_t WS_KV = WS_WL + 32 * MiB;
constexpr size_t  KV_WKV = 0, KV_MATS = 16 * MiB, KV_MEMB = 48 * MiB;
constexpr size_t WS_FFW = WS_KV + 56 * MiB;
constexpr size_t  FW_W13 = 0, FW_W2 = 112 * MiB;
constexpr size_t WS_ACT = WS_FFW + 168 * MiB;
constexpr size_t  A_UC = 0, A_UPOOL = 48 * MiB, A_GATES = 80 * MiB, A_EBUF = 208 * MiB, A_YSG = 240 * MiB, A_POOLED = 272 * MiB, A_POOLOUT = 304 * MiB,
                  A_SSMOUT = 336 * MiB, A_INNER = 368 * MiB, A_MIX_END = 432 * MiB;
constexpr size_t  A_Q = 0, A_P = 64 * MiB, A_AO = 128 * MiB;
constexpr size_t  A_H = 0;
constexpr size_t  A_TOKINFO = 0, A_TOKPOS = 1 * MiB, A_XS = 2 * MiB, A_Y = 2 * MiB, A_HM = 136 * MiB, A_MOE_END = A_HM + (size_t)MOE_ROWS * FFE * 2;
constexpr size_t WS_END = WS_ACT + ((A_MOE_END + MiB - 1) / MiB) * MiB;
static_assert((size_t)MOE_ROWS * D * 2 <= 134 * MiB, "XS/Y size");
static_assert(A_MOE_END >= A_MIX_END, "union");

constexpr int CW_BAR = 4096;
constexpr int CW_WGHIST = 16384;
constexpr int CW_META = 32768;

constexpr int RING_BYTES = 131072;
constexpr int XL_OFF = RING_BYTES;
constexpr int MISC_OFF = XL_OFF + 8192;
constexpr int LDS_BYTES = 147456;

#define XB_TMO      128
#define XB_XCNT(j)  (256  + 64 * (j))
#define XB_XSUB(j)  (1280 + 64 * (j))
#define XB_XGEN(j)  (2304 + 64 * (j))
#define XB_TOP      3328
#define XB_TOPGEN   3392
#define XCD_BAR_WORDS 3456
#define XB_SPIN_CAP (1u << 18)
__device__ __forceinline__ unsigned xb_ld(unsigned* p)              { return __hip_atomic_load(p, __ATOMIC_RELAXED, __HIP_MEMORY_SCOPE_AGENT); }
__device__ __forceinline__ unsigned xb_add(unsigned* p, unsigned v) { return __hip_atomic_fetch_add(p, v, __ATOMIC_RELAXED, __HIP_MEMORY_SCOPE_AGENT); }
__device__ __forceinline__ unsigned xb_xcc_id() { return (unsigned)__builtin_amdgcn_s_getreg((3 << 11) | 20) & 0xFu; }
#define XB_SPIN(cond, bar) do { unsigned _sp = 0; while (cond) { __builtin_amdgcn_s_sleep(1); \
    if ((++_sp & 255u) == 0u) { if (xb_ld(&(bar)[XB_TMO])) break; if (_sp > XB_SPIN_CAP) { atomicAdd(&(bar)[XB_TMO], 1u); break; } } } } while (0)
struct XcdBarrier { unsigned* bar; unsigned x; volatile LAS unsigned* st; };
__device__ __forceinline__ XcdBarrier xcd_barrier_post(unsigned* bar, volatile LAS unsigned* st) {
    XcdBarrier b; b.bar = bar; b.x = xb_xcc_id(); b.st = st;
    if (threadIdx.x == 0) (void)xb_add(&bar[XB_XCNT(b.x)], 1u);
    return b;
}
__device__ __forceinline__ void xcd_barrier_complete(unsigned* bar, unsigned x, unsigned& nloc, unsigned& nx) {
    const unsigned G = gridDim.x * gridDim.y * gridDim.z;
    unsigned sum, cnt, mine, sp = 0u;
    for (;;) {
        sum = 0u; cnt = 0u; mine = 0u;
#pragma unroll
        for (unsigned j = 0; j < 16; ++j) { const unsigned c = xb_ld(&bar[XB_XCNT(j)]); sum += c; cnt += (c > 0u) ? 1u : 0u; mine = (j == x) ? c : mine; }
        if (sum == G) break;
        __builtin_amdgcn_s_sleep(1);
        if ((++sp & 255u) == 0u) { if (xb_ld(&bar[XB_TMO])) break; if (sp > XB_SPIN_CAP) { atomicAdd(&bar[XB_TMO], 1u); break; } }
    }
    nloc = mine > 0u ? mine : 1u; nx = cnt > 0u ? cnt : 1u;
}
__device__ __forceinline__ void xcd_barrier(const XcdBarrier& b) {
    asm volatile("s_waitcnt vmcnt(0)" ::: "memory");
    __syncthreads();
    if (threadIdx.x == 0) {
        unsigned* bar = b.bar;
        __builtin_amdgcn_s_waitcnt(0);
        unsigned nloc = b.st[0], nx = b.st[1];
        if (nloc == 0u) { xcd_barrier_complete(bar, b.x, nloc, nx); b.st[0] = nloc; b.st[1] = nx; }
        const unsigned old = xb_add(&bar[XB_XSUB(b.x)], 1u);
        const unsigned gen = old / nloc;
        if (old + 1u == (gen + 1u) * nloc) {
            __builtin_amdgcn_fence(__ATOMIC_RELEASE, "agent");
            asm volatile("s_waitcnt vmcnt(0)" ::: "memory");
            const unsigned og = xb_add(&bar[XB_TOP], 1u);
            const unsigned tg = og / nx;
            if (og + 1u == (tg + 1u) * nx) xb_add(&bar[XB_TOPGEN], 1u);
            else XB_SPIN(xb_ld(&bar[XB_TOPGEN]) == tg, bar);
            __builtin_amdgcn_fence(__ATOMIC_ACQUIRE, "agent");
            xb_add(&bar[XB_XGEN(b.x)], 1u);
            asm volatile("s_waitcnt vmcnt(0)" ::: "memory");
        } else {
            XB_SPIN(xb_ld(&bar[XB_XGEN(b.x)]) == gen, bar);
            __builtin_amdgcn_fence(__ATOMIC_ACQUIRE, "agent");
            asm volatile("s_waitcnt vmcnt(0)" ::: "memory");
        }
    }
    __syncthreads();
}

typedef __bf16 bf16x2_t __attribute__((ext_vector_type(2)));
__device__ __forceinline__ unsigned cvt_pk_bf16(float lo, float hi) { const f32x2 v = {lo, hi}; const bf16x2_t b = __builtin_convertvector(v, bf16x2_t); return __builtin_bit_cast(unsigned, b); }
__device__ __forceinline__ float bf_lo(unsigned w) { return __uint_as_float(w << 16); }
__device__ __forceinline__ float bf_hi(unsigned w) { return __uint_as_float(w & 0xffff0000u); }
__device__ __forceinline__ float fast_sigmoid(float x) { return __builtin_amdgcn_rcpf(1.0f + __builtin_amdgcn_exp2f(-1.4426950408889634f * x)); }
__device__ __forceinline__ float gelu_tanh(float x) { const float u = 0.7978845608028654f * (x + 0.044715f * x * x * x); return x * fast_sigmoid(2.0f * u); }
__device__ __forceinline__ float wave_sum(float v) {
#pragma unroll
    for (int o = 1; o < 64; o <<= 1) v += __shfl_xor(v, o);
    return v;
}
__device__ __forceinline__ int wave_sum_i(int v) {
#pragma unroll
    for (int o = 1; o < 64; o <<= 1) v += __shfl_xor(v, o);
    return v;
}
#define LDS_WAIT() asm volatile("s_waitcnt lgkmcnt(0)" ::: "memory")
#define VM_WAIT() asm volatile("s_waitcnt vmcnt(0)" ::: "memory")

namespace pg8 {
constexpr int BM = 256, BK = 64, HALF = 128, HTB = HALF * BK * 2, STAGE_BYTES = 8 * HTB, NXCD = 8, WGM = 8;
__host__ __device__ __forceinline__ int lds_byte(int r, int c) { const int st = (r >> 4) * 2 + (c >> 5), rr = r & 15, cc = c & 31, ob = rr * 64 + cc * 2; return st * 1024 + (ob ^ (((ob >> 9) & 1) << 5)); }
__host__ __device__ __forceinline__ void stage_rc(int b, int& R, int& C) { const int st = b / 1024, sb = b % 1024, swz = sb ^ (((sb >> 9) & 1) << 5); R = (st >> 1) * 16 + swz / 64; C = (st & 1) * 32 + (swz % 64) / 2; }
__host__ __device__ __forceinline__ int perm32(int rho) { const int n = rho >> 4, i = rho & 15; return 8 * (i >> 2) + 4 * n + (i & 3); }

struct Unit { int pm, pn, g; };

__device__ __forceinline__ bool static_order(long L, int nM, int nN, Unit& u) {
    const int nwg = nM * nN; if (L >= nwg) return false;
    int wgid = (int)L; { const int q = nwg / NXCD, r = nwg % NXCD, xcd = wgid % NXCD, off = wgid / NXCD; wgid = (xcd < r ? xcd * (q + 1) : r * (q + 1) + (xcd - r) * q) + off; }
    const int nig = WGM * nN, gid = wgid / nig, fm = gid * WGM, gsz = (nM - fm) < WGM ? (nM - fm) : WGM;
    u.pm = fm + ((wgid % nig) % gsz); u.pn = (wgid % nig) / gsz; u.g = 0; return true;
}

#if !MK_DIRECT
template <class Epi, class Sched>
__device__ __forceinline__ void gemm_phase(LAS unsigned char* lds, LAS unsigned char* xl, const Sched& S, const Epi& E) {
    int tid_ = threadIdx.x; asm volatile("" : "+v"(tid_));
    const int tid = tid_, wid = __builtin_amdgcn_readfirstlane(tid >> 6), lane = tid & 63, wr = wid >> 2, wc = wid & 3, fr = lane & 15, fq = lane >> 4;
    const int K = S.K, nt = K / BK, lda = S.lda, ldb = S.ldb;
    unsigned voffA[2], voffB[2];
#pragma unroll
    for (int i = 0; i < 2; ++i) { int R, C; stage_rc(tid * 16 + i * 8192, R, C); const int Rb = Epi::PERM ? ((R & ~31) + perm32(R & 31)) : R;
        voffA[i] = (unsigned)(R * lda + C) * 2u; voffB[i] = (unsigned)(Rb * ldb + C) * 2u; }
    const size_t kstep = (size_t)(BK * 2);
    const size_t hstepA = (size_t)HALF * lda * 2, hstepB = (size_t)HALF * ldb * 2;
    const unsigned ldsw = (unsigned)wid * 1024u;
    const int aoff = lds_byte(wr * 64 + fr, fq * 8), boff = lds_byte(wc * 32 + fr, fq * 8);
#define PG8_SA(b, h) (((b) * 2 + (h)) * HTB)
#define PG8_SB(b, h) ((4 + (b) * 2 + (h)) * HTB)
#define PG8_STAGE(bufoff, gbase, voff) do { _Pragma("unroll") for (int _i = 0; _i < 2; ++_i) \
        __builtin_amdgcn_global_load_lds((const unsigned*)((const char*)(gbase) + (voff)[_i]), (LAS unsigned*)(lds + (bufoff) + ldsw + _i * 8192), 16, 0, 0); } while (0)
#define PG8_LDA(dst, b, h) do { _Pragma("unroll") for (int m = 0; m < 4; ++m) _Pragma("unroll") for (int k = 0; k < 2; ++k) dst[m][k] = *(const LAS bf16x8*)(lds + PG8_SA(b, h) + aoff + m * 2048 + k * 1024); } while (0)
#define PG8_LDB(dst, b, h) do { _Pragma("unroll") for (int n = 0; n < 2; ++n) _Pragma("unroll") for (int k = 0; k < 2; ++k) dst[n][k] = *(const LAS bf16x8*)(lds + PG8_SB(b, h) + boff + n * 2048 + k * 1024); } while (0)
#define PG8_MMA(ai, bj, At, Bt) do { __builtin_amdgcn_s_setprio(1); _Pragma("unroll") for (int m = 0; m < 4; ++m) _Pragma("unroll") for (int n = 0; n < 2; ++n) _Pragma("unroll") for (int k = 0; k < 2; ++k) \
        acc[ai][bj][m][n] = __builtin_amdgcn_mfma_f32_16x16x32_bf16(Bt[n][k], At[m][k], acc[ai][bj][m][n], 0, 0, 0); __builtin_amdgcn_s_setprio(0); } while (0)
#define PG8_WAIT_V(n) asm volatile("s_waitcnt vmcnt(" #n ")" ::: "memory")
#define PG8_WAIT_L(n) asm volatile("s_waitcnt lgkmcnt(" #n ")" ::: "memory")
#define PG8_BAR __builtin_amdgcn_s_barrier()
#define PG8_SCHED __builtin_amdgcn_sched_barrier(0)
    Unit cur, nxt; int ui = 0;
    if (!S.next(0, cur)) return;
    f32x4 acc[2][2][4][2];
#pragma unroll
    for (int a = 0; a < 2; ++a)
#pragma unroll
        for (int b = 0; b < 2; ++b)
#pragma unroll
            for (int m = 0; m < 4; ++m)
#pragma unroll
                for (int n = 0; n < 2; ++n) acc[a][b][m][n] = (f32x4){0.f, 0.f, 0.f, 0.f};
    bf16x8 At[4][2], B0[2][2], B1[2][2];
    const char* cA = S.a_tile(cur); const char* cB = S.b_tile(cur);
    PG8_STAGE(PG8_SB(0, 0), cB, voffB); PG8_STAGE(PG8_SB(0, 1), cB + hstepB, voffB); PG8_STAGE(PG8_SA(0, 0), cA, voffA); PG8_STAGE(PG8_SA(0, 1), cA + hstepA, voffA);
    if (wr == 1) PG8_BAR;
    PG8_WAIT_V(2); PG8_BAR;
    PG8_STAGE(PG8_SB(1, 0), cB + kstep, voffB); PG8_STAGE(PG8_SA(1, 0), cA + kstep, voffA); PG8_STAGE(PG8_SB(1, 1), cB + hstepB + kstep, voffB);
    PG8_WAIT_V(6); PG8_BAR;
    for (;;) {
        const bool has_next = S.next(ui + 1, nxt);
        const char* nA = has_next ? S.a_tile(nxt) : cA; const char* nB = has_next ? S.b_tile(nxt) : cB;
        for (int t = 0; t < nt; t += 2) {
            const bool last = (t == nt - 2);
            const char* a1 = cA + (size_t)(t + 1) * kstep;
            const char* a2 = last ? nA : cA + (size_t)(t + 2) * kstep; const char* b2 = last ? nB : cB + (size_t)(t + 2) * kstep;
            const char* a3 = a2 + kstep; const char* b3 = b2 + kstep;
            PG8_LDB(B0, 0, 0); PG8_LDB(B1, 0, 1); PG8_SCHED; PG8_LDA(At, 0, 0); PG8_STAGE(PG8_SA(1, 1), a1 + hstepA, voffA);
            PG8_WAIT_V(8); PG8_WAIT_L(0); PG8_BAR; PG8_MMA(0, 0, At, B0); PG8_MMA(0, 1, At, B1); PG8_BAR; PG8_SCHED;
            PG8_LDA(At, 0, 1); PG8_STAGE(PG8_SB(0, 0), b2, voffB); PG8_STAGE(PG8_SB(0, 1), b2 + hstepB, voffB); PG8_STAGE(PG8_SA(0, 0), a2, voffA);
            PG8_WAIT_V(8); PG8_WAIT_L(0); PG8_BAR; PG8_MMA(1, 0, At, B0); PG8_MMA(1, 1, At, B1); PG8_BAR; PG8_SCHED;
            PG8_LDB(B0, 1, 0); PG8_LDB(B1, 1, 1); PG8_SCHED; PG8_LDA(At, 1, 0); PG8_STAGE(PG8_SA(0, 1), a2 + hstepA, voffA);
            PG8_WAIT_V(8); PG8_WAIT_L(0); PG8_BAR; PG8_MMA(0, 0, At, B0); PG8_MMA(0, 1, At, B1); PG8_BAR; PG8_SCHED;
            PG8_LDA(At, 1, 1); PG8_STAGE(PG8_SB(1, 0), b3, voffB); PG8_STAGE(PG8_SB(1, 1), b3 + hstepB, voffB); PG8_STAGE(PG8_SA(1, 0), a3, voffA);
            PG8_WAIT_V(8); PG8_WAIT_L(0); PG8_BAR; PG8_MMA(1, 0, At, B0); PG8_MMA(1, 1, At, B1); PG8_BAR; PG8_SCHED;
        }
        if (wr == 0) PG8_BAR;
        { int fr2 = fr, fq2 = fq; asm volatile("" : "+v"(fr2), "+v"(fq2));
          E(acc, cur, wr, wc, fr2, fq2, xl); }
        if (!has_next) break;
#pragma unroll
        for (int a = 0; a < 2; ++a)
#pragma unroll
            for (int b = 0; b < 2; ++b)
#pragma unroll
                for (int m = 0; m < 4; ++m)
#pragma unroll
                    for (int n = 0; n < 2; ++n) acc[a][b][m][n] = (f32x4){0.f, 0.f, 0.f, 0.f};
        cur = nxt; cA = nA; cB = nB; ++ui;
        if (wr == 1) PG8_BAR;
    }
    PG8_WAIT_V(0);
    PG8_BAR;
#undef PG8_SA
#undef PG8_SB
#undef PG8_STAGE
#undef PG8_LDA
#undef PG8_LDB
#undef PG8_MMA
#undef PG8_WAIT_V
#undef PG8_WAIT_L
#undef PG8_BAR
#undef PG8_SCHED
}
#else
template <class Epi, class Sched>
__device__ __forceinline__ void gemm_phase(LAS unsigned char* lds, LAS unsigned char* xl, const Sched& S, const Epi& E) {
    int tid_ = threadIdx.x; asm volatile("" : "+v"(tid_));
    const int tid = tid_, wid = __builtin_amdgcn_readfirstlane(tid >> 6), lane = tid & 63, wr = wid >> 2, wc = wid & 3, fr = lane & 15, fq = lane >> 4;
    const int K = S.K, nt = K / BK, lda = S.lda, ldb = S.ldb;
    unsigned offA[4], offB[2];
#pragma unroll
    for (int m = 0; m < 4; ++m) offA[m] = (unsigned)((64 * wr + 16 * m + fr) * lda + fq * 8) * 2u;
#pragma unroll
    for (int n = 0; n < 2; ++n) offB[n] = (unsigned)((32 * wc + (Epi::PERM ? perm32(16 * n + fr) : (16 * n + fr))) * ldb + fq * 8) * 2u;
    Unit cur;
    for (int ui = 0; S.next(ui, cur); ++ui) {
        f32x4 acc[2][2][4][2];
#pragma unroll
        for (int a = 0; a < 2; ++a)
#pragma unroll
            for (int b = 0; b < 2; ++b)
#pragma unroll
                for (int m = 0; m < 4; ++m)
#pragma unroll
                    for (int n = 0; n < 2; ++n) acc[a][b][m][n] = (f32x4){0.f, 0.f, 0.f, 0.f};
        const char* A = S.a_tile(cur); const char* B = S.b_tile(cur);
#pragma unroll 1
        for (int kt = 0; kt < nt; ++kt) {
#pragma unroll
            for (int ai = 0; ai < 2; ++ai) {
                bf16x8 At[4][2]; const char* Ab = A + (size_t)ai * 128 * lda * 2 + kt * 128;
#pragma unroll
                for (int m = 0; m < 4; ++m)
#pragma unroll
                    for (int k = 0; k < 2; ++k) At[m][k] = *(const bf16x8*)(Ab + k * 64 + offA[m]);
#pragma unroll
                for (int bj = 0; bj < 2; ++bj) {
                    bf16x8 Bf[2][2]; const char* Bb = B + (size_t)bj * 128 * ldb * 2 + kt * 128;
#pragma unroll
                    for (int n = 0; n < 2; ++n)
#pragma unroll
                        for (int k = 0; k < 2; ++k) Bf[n][k] = *(const bf16x8*)(Bb + k * 64 + offB[n]);
#pragma unroll
                    for (int m = 0; m < 4; ++m)
#pragma unroll
                        for (int n = 0; n < 2; ++n)
#pragma unroll
                            for (int k = 0; k < 2; ++k) acc[ai][bj][m][n] = __builtin_amdgcn_mfma_f32_16x16x32_bf16(Bf[n][k], At[m][k], acc[ai][bj][m][n], 0, 0, 0);
                }
            }
            asm volatile("" ::: "memory");
        }
        { int fr2 = fr, fq2 = fq; asm volatile("" : "+v"(fr2), "+v"(fq2)); E(acc, cur, wr, wc, fr2, fq2, xl); }
    }
    __syncthreads();
}
#endif

struct SchedPlain {
    const bf16_t* A; const bf16_t* B; int lda, ldb, K, nM, nN, G, c;
    __device__ __forceinline__ bool next(int i, Unit& u) const { return static_order((long)i * G + c, nM, nN, u); }
    __device__ __forceinline__ const char* a_tile(const Unit& u) const { return (const char*)(A + (size_t)u.pm * BM * lda); }
    __device__ __forceinline__ const char* b_tile(const Unit& u) const { return (const char*)(B + (size_t)u.pn * BM * ldb); }
};
struct SchedSsm {
    const bf16_t* A; const bf16_t* B; int lda, ldb, K, G, c;
    __device__ __forceinline__ bool next(int i, Unit& u) const { const int L = i * G + c; if (L >= NG * 8) return false; u.g = L >> 3; u.pm = L & 7; u.pn = 0; return true; }
    __device__ __forceinline__ const char* a_tile(const Unit& u) const { return (const char*)(A + ((size_t)u.g * CROWS + (size_t)u.pm * BM) * lda); }
    __device__ __forceinline__ const char* b_tile(const Unit& u) const { return (const char*)(B + (size_t)u.g * 256 * ldb); }
};
struct SchedAttn {
    const bf16_t* A; const bf16_t* B; int lda, ldb, K, G, c, pv;
    __device__ __forceinline__ bool next(int i, Unit& u) const { const int L = i * G + c; if (L >= NB * NH * 16) return false; const int bh = L >> 4, rt = L & 15; u.g = bh >> 2; u.pn = bh & 3; u.pm = u.g * 16 + rt; return true; }
    __device__ __forceinline__ const char* a_tile(const Unit& u) const { return (const char*)(A + (size_t)u.pm * BM * lda + u.pn * HD); }
    __device__ __forceinline__ const char* b_tile(const Unit& u) const { return (const char*)(pv ? (B + (size_t)u.pn * HD * ldb + u.g * NMEM) : (B + (size_t)u.g * NMEM * ldb + u.pn * HD)); }
};
struct SchedKv {
    const bf16_t* wkv; const bf16_t* memb; int lda, ldb, K, G, c;
    __device__ __forceinline__ bool next(int i, Unit& u) const { const int L = i * G + c; if (L >= DEPTH * 64) return false; u.g = L >> 5; const int r = L & 31; if (u.g & 1) { u.pm = r >> 3; u.pn = r & 7; } else { u.pm = r >> 2; u.pn = r & 3; } return true; }
    __device__ __forceinline__ const char* a_tile(const Unit& u) const { return (const char*)((u.g & 1) ? (wkv + (size_t)u.g * D * D + (size_t)u.pm * BM * D) : (memb + (size_t)u.pm * BM * D)); }
    __device__ __forceinline__ const char* b_tile(const Unit& u) const { return (const char*)((u.g & 1) ? (memb + (size_t)u.pn * BM * D) : (wkv + (size_t)u.g * D * D + (size_t)u.pn * BM * D)); }
};
struct SchedMoe {
    const bf16_t* A; const bf16_t* B; const unsigned* meta; int lda, ldb, K, nM, nN, G, c;
    __device__ __forceinline__ bool next(int i, Unit& u) const { if (!static_order((long)i * G + c, nM, nN, u)) return false; u.g = (int)meta[16 + u.pm]; return true; }
    __device__ __forceinline__ const char* a_tile(const Unit& u) const { return (const char*)(A + (size_t)u.pm * BM * lda); }
    __device__ __forceinline__ const char* b_tile(const Unit& u) const { return (const char*)(B + ((size_t)u.g * nN * BM + (size_t)u.pn * BM) * ldb); }
};

#define EPI_ARGS f32x4 (&acc)[2][2][4][2], const Unit& u, int wr, int wc, int fr, int fq, LAS unsigned char* xl
#define FOR_ROWS _Pragma("unroll") for (int ai = 0; ai < 2; ++ai) _Pragma("unroll") for (int m = 0; m < 4; ++m)
#define FOR_BJ _Pragma("unroll") for (int bj = 0; bj < 2; ++bj)
__device__ __forceinline__ u32x4 pack8(const f32x4 a, const f32x4 b) { u32x4 w; w.x = cvt_pk_bf16(a[0], a[1]); w.y = cvt_pk_bf16(a[2], a[3]); w.z = cvt_pk_bf16(b[0], b[1]); w.w = cvt_pk_bf16(b[2], b[3]); return w; }

struct EpiProj { static constexpr bool PERM = true; bf16_t* uc; bf16_t* upool; bf16_t* gates;
    __device__ __forceinline__ void operator()(EPI_ARGS) const {
        FOR_ROWS { const int row = u.pm * 256 + ai * 128 + wr * 64 + m * 16 + fr;
            FOR_BJ { const int col = u.pn * 256 + bj * 128 + wc * 32 + 8 * fq; f32x4 v0 = acc[ai][bj][m][0], v1 = acc[ai][bj][m][1];
                if (u.pn < 2) { *(u32x4*)(uc + ((size_t)(col >> 4) * CROWS + (row >> 4)) * UCLD + (row & 15) * 16 + (col & 15)) = pack8(v0, v1); }
                else if (u.pn < 4) { *(u32x4*)(upool + (size_t)row * 512 + (col - 512)) = pack8(v0, v1); }
                else {
#pragma unroll
                    for (int j = 0; j < 4; ++j) { v0[j] = fast_sigmoid(v0[j]); v1[j] = fast_sigmoid(v1[j]); }
                    *(u32x4*)(gates + (size_t)row * 2048 + (col - 1024)) = pack8(v0, v1); } }
            asm volatile("" ::: "memory"); }
    }
};
struct EpiBf16 { static constexpr bool PERM = true; bf16_t* O; int ldc; float scale; size_t gstride;
    __device__ __forceinline__ void operator()(EPI_ARGS) const {
        bf16_t* base = O + (size_t)u.g * gstride;
        FOR_ROWS { const int row = u.pm * 256 + ai * 128 + wr * 64 + m * 16 + fr;
            FOR_BJ { const int col = u.pn * 256 + bj * 128 + wc * 32 + 8 * fq;
                *(u32x4*)(base + (size_t)row * ldc + col) = pack8(acc[ai][bj][m][0] * scale, acc[ai][bj][m][1] * scale); } }
    }
};
struct EpiKv { static constexpr bool PERM = true; bf16_t* mats;
    __device__ __forceinline__ void operator()(EPI_ARGS) const {
        const int isv = u.g & 1; bf16_t* base = mats + (size_t)(u.g >> 1) * (2 * MROWS * D) + (isv ? (size_t)MROWS * D : 0); const int ldc = isv ? MROWS : D;
        FOR_ROWS { const int row = u.pm * 256 + ai * 128 + wr * 64 + m * 16 + fr;
            FOR_BJ { const int col = u.pn * 256 + bj * 128 + wc * 32 + 8 * fq;
                *(u32x4*)(base + (size_t)row * ldc + col) = pack8(acc[ai][bj][m][0], acc[ai][bj][m][1]); } }
    }
};
struct EpiSsmE { static constexpr bool PERM = false; float* E;
    __device__ __forceinline__ void operator()(EPI_ARGS) const {
        FOR_ROWS { const int row = u.pm * 256 + ai * 128 + wr * 64 + m * 16 + fr;
#pragma unroll
            for (int n = 0; n < 2; ++n) { const int col = wc * 32 + 16 * n + 4 * fq;
                *(f32x4*)(E + ((size_t)u.g * CROWS + row) * 128 + col) = acc[ai][0][m][n]; } }
    }
};
struct EpiSsmY { static constexpr bool PERM = true; const bf16_t* uc; const float* dvec; bf16_t* ysg;
    __device__ __forceinline__ void operator()(EPI_ARGS) const {
        const int c0 = (8 * fq) & 15;
        const f32x4 d0 = *(const f32x4*)(dvec + u.g * 16 + c0), d1 = *(const f32x4*)(dvec + u.g * 16 + c0 + 4);
        FOR_ROWS { const int R = u.pm * 256 + ai * 128 + wr * 64 + m * 16 + fr;
            FOR_BJ { const int n0 = bj * 128 + wc * 32 + 8 * fq, tt = n0 >> 4;
                const u32x4 uu = *(const u32x4*)(uc + ((size_t)u.g * CROWS + R) * UCLD + n0);
                f32x4 v0 = acc[ai][bj][m][0], v1 = acc[ai][bj][m][1];
                v0[0] += d0[0] * bf_lo(uu.x); v0[1] += d0[1] * bf_hi(uu.x); v0[2] += d0[2] * bf_lo(uu.y); v0[3] += d0[3] * bf_hi(uu.y);
                v1[0] += d1[0] * bf_lo(uu.z); v1[1] += d1[1] * bf_hi(uu.z); v1[2] += d1[2] * bf_lo(uu.w); v1[3] += d1[3] * bf_hi(uu.w);
#pragma unroll
                for (int j = 0; j < 4; ++j) { v0[j] = gelu_tanh(v0[j]); v1[j] = gelu_tanh(v1[j]); }
                *(u32x4*)(ysg + ((size_t)R * 16 + tt) * 512 + u.g * 16 + c0) = pack8(v0, v1); }
            asm volatile("" ::: "memory"); }
    }
};
struct EpiGlu { static constexpr bool PERM = true; const bf16_t* ysg; const float* bias; bf16_t* out;
    __device__ __forceinline__ void operator()(EPI_ARGS) const {
        FOR_ROWS { const int row = u.pm * 256 + ai * 128 + wr * 64 + m * 16 + fr;
            FOR_BJ { const int col = u.pn * 256 + bj * 128 + wc * 32 + 8 * fq;
                const u32x4 yy = *(const u32x4*)(ysg + (size_t)row * 512 + col);
                const f32x4 b0 = *(const f32x4*)(bias + col), b1 = *(const f32x4*)(bias + col + 4);
                f32x4 v0 = acc[ai][bj][m][0] + b0, v1 = acc[ai][bj][m][1] + b1;
                v0[0] = bf_lo(yy.x) * fast_sigmoid(v0[0]); v0[1] = bf_hi(yy.x) * fast_sigmoid(v0[1]); v0[2] = bf_lo(yy.y) * fast_sigmoid(v0[2]); v0[3] = bf_hi(yy.y) * fast_sigmoid(v0[3]);
                v1[0] = bf_lo(yy.z) * fast_sigmoid(v1[0]); v1[1] = bf_hi(yy.z) * fast_sigmoid(v1[1]); v1[2] = bf_lo(yy.w) * fast_sigmoid(v1[2]); v1[3] = bf_hi(yy.w) * fast_sigmoid(v1[3]);
                *(u32x4*)(out + (size_t)row * 512 + col) = pack8(v0, v1); }
            asm volatile("" ::: "memory"); }
    }
};
template <bool ADD> struct EpiUp { static constexpr bool PERM = true; const bf16_t* gates; bf16_t* inner;
    __device__ __forceinline__ void operator()(EPI_ARGS) const {
        FOR_ROWS { const int row = u.pm * 256 + ai * 128 + wr * 64 + m * 16 + fr;
            FOR_BJ { const int col = u.pn * 256 + bj * 128 + wc * 32 + 8 * fq;
                const u32x4 gg = *(const u32x4*)(gates + (size_t)row * 2048 + col);
                f32x4 v0 = acc[ai][bj][m][0], v1 = acc[ai][bj][m][1];
                v0[0] *= bf_lo(gg.x); v0[1] *= bf_hi(gg.x); v0[2] *= bf_lo(gg.y); v0[3] *= bf_hi(gg.y);
                v1[0] *= bf_lo(gg.z); v1[1] *= bf_hi(gg.z); v1[2] *= bf_lo(gg.w); v1[3] *= bf_hi(gg.w);
                if (ADD) { const u32x4 pp = *(const u32x4*)(inner + (size_t)row * D + col);
                    v0[0] += bf_lo(pp.x); v0[1] += bf_hi(pp.x); v0[2] += bf_lo(pp.y); v0[3] += bf_hi(pp.y);
                    v1[0] += bf_lo(pp.z); v1[1] += bf_hi(pp.z); v1[2] += bf_lo(pp.w); v1[3] += bf_hi(pp.w); }
                *(u32x4*)(inner + (size_t)row * D + col) = pack8(v0, v1); }
            asm volatile("" ::: "memory"); }
    }
};
struct EpiRes { static constexpr bool PERM = false; float* x;
    __device__ __forceinline__ void operator()(EPI_ARGS) const {
        FOR_ROWS { float* rowp = x + (size_t)(u.pm * 256 + ai * 128 + wr * 64 + m * 16 + fr) * D + u.pn * 256 + wc * 32 + 4 * fq;
            FOR_BJ {
#pragma unroll
                for (int n = 0; n < 2; ++n) { float* p = rowp + bj * 128 + n * 16; const f32x4 xv = *(const f32x4*)p; *(f32x4*)p = xv * ALPHA + acc[ai][bj][m][n]; } }
            asm volatile("" ::: "memory"); }
    }
};
struct EpiSoftmax { static constexpr bool PERM = true; bf16_t* P;
    __device__ __forceinline__ void operator()(EPI_ARGS) const {
        LAS f32x2* tab = (LAS f32x2*)xl;
        float mloc[2][4];
        FOR_ROWS { const int r = ai * 128 + wr * 64 + m * 16 + fr;
            float mx = -3.0e38f;
            FOR_BJ {
#pragma unroll
                for (int n = 0; n < 2; ++n)
#pragma unroll
                    for (int j = 0; j < 4; ++j) mx = fmaxf(mx, acc[ai][bj][m][n][j]); }
            mx = fmaxf(mx, __shfl_xor(mx, 16)); mx = fmaxf(mx, __shfl_xor(mx, 32));
            float s = 0.f;
            FOR_BJ {
#pragma unroll
                for (int n = 0; n < 2; ++n)
#pragma unroll
                    for (int j = 0; j < 4; ++j) { const float e = __builtin_amdgcn_exp2f((acc[ai][bj][m][n][j] - mx) * 1.4426950408889634f); acc[ai][bj][m][n][j] = e; s += e; } }
            s += __shfl_xor(s, 16); s += __shfl_xor(s, 32);
            mloc[ai][m] = mx;
            if (fq == 0) tab[r * 4 + wc] = (f32x2){mx, s};
        }
        LDS_WAIT(); __builtin_amdgcn_s_barrier(); asm volatile("" ::: "memory");
        FOR_ROWS { const int r = ai * 128 + wr * 64 + m * 16 + fr;
            const f32x2 t0 = tab[r * 4 + 0], t1 = tab[r * 4 + 1], t2 = tab[r * 4 + 2], t3 = tab[r * 4 + 3];
            const float M = fmaxf(fmaxf(t0.x, t1.x), fmaxf(t2.x, t3.x));
            const float tot = t0.y * __builtin_amdgcn_exp2f((t0.x - M) * 1.4426950408889634f) + t1.y * __builtin_amdgcn_exp2f((t1.x - M) * 1.4426950408889634f)
                            + t2.y * __builtin_amdgcn_exp2f((t2.x - M) * 1.4426950408889634f) + t3.y * __builtin_amdgcn_exp2f((t3.x - M) * 1.4426950408889634f);
            const float f = __builtin_amdgcn_exp2f((mloc[ai][m] - M) * 1.4426950408889634f) / tot;
            const int row = u.pm * 256 + r;
            FOR_BJ { const int col = u.pn * 256 + bj * 128 + wc * 32 + 8 * fq;
                *(u32x4*)(P + (size_t)row * D + col) = pack8(acc[ai][bj][m][0] * f, acc[ai][bj][m][1] * f); } }
        LDS_WAIT(); __builtin_amdgcn_s_barrier(); asm volatile("" ::: "memory");
    }
};
struct EpiSwiglu { static constexpr bool PERM = true; bf16_t* H; int ldh;
    __device__ __forceinline__ void operator()(EPI_ARGS) const {
        FOR_ROWS { const int row = u.pm * 256 + ai * 128 + wr * 64 + m * 16 + fr;
            FOR_BJ { const int hid = u.pn * 128 + bj * 64 + wc * 16 + 4 * fq; const f32x4 a = acc[ai][bj][m][0], b = acc[ai][bj][m][1]; f32x4 h;
#pragma unroll
                for (int j = 0; j < 4; ++j) h[j] = a[j] * fast_sigmoid(a[j]) * b[j];
                u32x2 w; w.x = cvt_pk_bf16(h[0], h[1]); w.y = cvt_pk_bf16(h[2], h[3]);
                *(u32x2*)(H + (size_t)row * ldh + hid) = w; } }
    }
};
}

struct Args { const float* in[35]; float* out; unsigned char* ws; int ph_lo, ph_hi; };
struct Frame {
    LAS unsigned char* lds; volatile LAS unsigned* MISC; unsigned* ctl;
    int tid, lane, wave, G, gw, NGW;
    unsigned char* ws; float* x; bf16_t* xb;
};
constexpr int NWAVES = 8;

__device__ __forceinline__ void transpose_item(const float* W, int K, int N, bf16_t* WT, int row_off, int mode, LAS float* scr, int item, int lane) {
    const int nblk = N / 32, kb = item / nblk, nb = item % nblk, k0 = 64 * kb, n0 = 32 * nb;
#pragma unroll 8
    for (int i = 0; i < 32; ++i) { const int kk = 2 * i + (lane >> 5); scr[kk * 33 + (lane & 31)] = W[(size_t)(k0 + kk) * N + n0 + (lane & 31)]; }
    LDS_WAIT(); asm volatile("" ::: "memory");
    const int c = lane & 7;
#pragma unroll
    for (int j = 0; j < 4; ++j) { const int n = (lane >> 3) + 8 * j; const LAS float* s = scr + (8 * c) * 33 + n;
        u32x4 o; o.x = cvt_pk_bf16(s[0 * 33], s[1 * 33]); o.y = cvt_pk_bf16(s[2 * 33], s[3 * 33]); o.z = cvt_pk_bf16(s[4 * 33], s[5 * 33]); o.w = cvt_pk_bf16(s[6 * 33], s[7 * 33]);
        const int nn = n0 + n; const int row = mode == 0 ? (row_off + nn) : (8 * (nn >> 2) + (nn & 3) + (mode == 2 ? 4 : 0));
        *(u32x4*)(WT + (size_t)row * K + k0 + 8 * c) = o; }
    LDS_WAIT(); asm volatile("" ::: "memory");
}
__device__ __forceinline__ void transpose_all(Frame& F, const float* W, int K, int N, bf16_t* WT, int row_off, int mode) {
    LAS float* scr = (LAS float*)(F.lds + F.wave * 16384);
    const int nit = (K / 64) * (N / 32);
    for (int it = F.gw; it < nit; it += F.NGW) transpose_item(W, K, N, WT, row_off, mode, scr, it, F.lane);
}

__device__ __forceinline__ void ln_regs(f32x4 (&v)[4], const f32x4 (&gv)[4], const f32x4 (&bv)[4]) {
    float s = 0.f;
#pragma unroll
    for (int j = 0; j < 4; ++j) s += (v[j].x + v[j].y) + (v[j].z + v[j].w);
    const float mean = wave_sum(s) * (1.f / D); float s2 = 0.f;
#pragma unroll
    for (int j = 0; j < 4; ++j) { v[j] = v[j] - mean; s2 += (v[j].x * v[j].x + v[j].y * v[j].y) + (v[j].z * v[j].z + v[j].w * v[j].w); }
    const float rstd = 1.f / sqrtf(wave_sum(s2) * (1.f / D) + LN_EPS);
#pragma unroll
    for (int j = 0; j < 4; ++j) v[j] = v[j] * rstd * gv[j] + bv[j];
}
__device__ __forceinline__ void store_row(Frame& F, int m, const f32x4 (&v)[4]) {
    f32x4* xr = (f32x4*)(F.x + (size_t)m * D) + F.lane; u32x2* o8 = (u32x2*)(F.xb + (size_t)m * D) + F.lane;
#pragma unroll
    for (int j = 0; j < 4; ++j) { xr[64 * j] = v[j]; u32x2 w; w.x = cvt_pk_bf16(v[j].x, v[j].y); w.y = cvt_pk_bf16(v[j].z, v[j].w); o8[64 * j] = w; }
}
template <int MODE>
__device__ __forceinline__ void ln_phase(Frame& F, const float* g, const float* b, const float* router, uint4* tokinfo, const uint2* tokpos, const bf16_t* Y) {
    f32x4 gv[4], bv[4];
#pragma unroll
    for (int j = 0; j < 4; ++j) { gv[j] = ((const f32x4*)g)[F.lane + 64 * j]; bv[j] = ((const f32x4*)b)[F.lane + 64 * j]; }
    LAS float* rt = (LAS float*)F.lds;
    LAS int* hist = (LAS int*)(F.lds + 32768);
    if (MODE == 1) {
        for (int i = F.tid; i < D * NE / 4; i += NWAVES * 64) ((LAS f32x4*)rt)[i] = ((const f32x4*)router)[i];
        if (F.tid < NE) hist[F.tid] = 0;
        __syncthreads();
    }
    for (int m = F.gw; m < T; m += F.NGW) {
        const f32x4* xr = (const f32x4*)(F.x + (size_t)m * D) + F.lane;
        f32x4 v[4];
#pragma unroll
        for (int j = 0; j < 4; ++j) v[j] = xr[64 * j];
        if (MODE == 2) {
            const uint4 ti = tokinfo[m]; const uint2 tp = tokpos[m]; const float w0 = __uint_as_float(ti.z), w1 = __uint_as_float(ti.w);
            const u32x2* y0 = (const u32x2*)(Y + (size_t)tp.x * D) + F.lane; const u32x2* y1 = (const u32x2*)(Y + (size_t)tp.y * D) + F.lane;
#pragma unroll
            for (int j = 0; j < 4; ++j) { const u32x2 a = y0[64 * j], c = y1[64 * j];
                v[j].x = ALPHA * v[j].x + w0 * bf_lo(a.x) + w1 * bf_lo(c.x); v[j].y = ALPHA * v[j].y + w0 * bf_hi(a.x) + w1 * bf_hi(c.x);
                v[j].z = ALPHA * v[j].z + w0 * bf_lo(a.y) + w1 * bf_lo(c.y); v[j].w = ALPHA * v[j].w + w0 * bf_hi(a.y) + w1 * bf_hi(c.y); }
        }
        ln_regs(v, gv, bv);
        store_row(F, m, v);
        if (MODE == 1) {
            float lg[NE];
#pragma unroll
            for (int e = 0; e < NE; ++e) lg[e] = 0.f;
#pragma unroll
            for (int j = 0; j < 4; ++j)
#pragma unroll
                for (int q = 0; q < 4; ++q) { const int k = 4 * F.lane + 256 * j + q; const f32x4 r0 = *(const LAS f32x4*)(rt + k * 8), r1 = *(const LAS f32x4*)(rt + k * 8 + 4); const float xv = v[j][q];
                    lg[0] += xv * r0.x; lg[1] += xv * r0.y; lg[2] += xv * r0.z; lg[3] += xv * r0.w; lg[4] += xv * r1.x; lg[5] += xv * r1.y; lg[6] += xv * r1.z; lg[7] += xv * r1.w; }
#pragma unroll
            for (int e = 0; e < NE; ++e) lg[e] = wave_sum(lg[e]);
            int e0 = 0; float v0 = lg[0];
#pragma unroll
            for (int e = 1; e < NE; ++e) if (lg[e] > v0) { v0 = lg[e]; e0 = e; }
            int e1 = -1; float v1 = -3.0e38f;
#pragma unroll
            for (int e = 0; e < NE; ++e) if (e != e0 && lg[e] > v1) { v1 = lg[e]; e1 = e; }
            const float ex = __expf(v1 - v0), w0 = 1.f / (1.f + ex), w1 = ex / (1.f + ex);
            if (F.lane == 0) { const int r0 = __hip_atomic_fetch_add(hist + e0, 1, __ATOMIC_RELAXED, __HIP_MEMORY_SCOPE_WORKGROUP), r1 = __hip_atomic_fetch_add(hist + e1, 1, __ATOMIC_RELAXED, __HIP_MEMORY_SCOPE_WORKGROUP);
                tokinfo[m] = make_uint4((unsigned)e0 | ((unsigned)r0 << 8), (unsigned)e1 | ((unsigned)r1 << 8), __float_as_uint(w0), __float_as_uint(w1)); }
        }
    }
    if (MODE == 1) { __syncthreads(); if (F.tid < NE) F.ctl[CW_WGHIST + blockIdx.x * 8 + F.tid] = (unsigned)hist[F.tid]; }
}

__device__ __forceinline__ void moe_gather_phase(Frame& F, const uint4* tokinfo, uint2* tokpos, bf16_t* XS) {
    LAS int* tot = (LAS int*)F.lds; LAS int* pre = tot + 8; LAS int* base = tot + 16;
    { const int e = F.wave; int st = 0, sp = 0;
      for (int w = F.lane; w < F.G; w += 64) { const int v = (int)F.ctl[CW_WGHIST + w * 8 + e]; st += v; if (w < (int)blockIdx.x) sp += v; }
      st = wave_sum_i(st); sp = wave_sum_i(sp); if (F.lane == 0) { tot[e] = st; pre[e] = sp; } }
    __syncthreads();
    if (F.tid == 0) { int off = 0;
        for (int e = 0; e < NE; ++e) { base[e] = off + pre[e]; const int nt = (tot[e] + 255) >> 8;
            if (blockIdx.x == 0) for (int t = 0; t < nt; ++t) F.ctl[CW_META + 16 + (off >> 8) + t] = (unsigned)e;
            off += nt << 8; }
        if (blockIdx.x == 0) F.ctl[CW_META] = (unsigned)(off >> 8); }
    __syncthreads();
    for (int m = F.gw; m < T; m += F.NGW) {
        const uint4 ti = tokinfo[m];
        const unsigned p0 = (unsigned)base[ti.x & 255u] + (ti.x >> 8), p1 = (unsigned)base[ti.y & 255u] + (ti.y >> 8);
        if (F.lane == 0) tokpos[m] = make_uint2(p0, p1);
        const u32x4* src = (const u32x4*)(F.xb + (size_t)m * D) + F.lane; u32x4* d0 = (u32x4*)(XS + (size_t)p0 * D) + F.lane; u32x4* d1 = (u32x4*)(XS + (size_t)p1 * D) + F.lane;
        const u32x4 a = src[0], c = src[64]; d0[0] = a; d0[64] = c; d1[0] = a; d1[64] = c;
    }
}

__device__ __forceinline__ void init_phase(Frame& F, const Args& a) {
    const f32x4* xs = (const f32x4*)a.in[0]; f32x4* xo = (f32x4*)F.x; u32x2* xbo = (u32x2*)F.xb;
    for (size_t i = (size_t)blockIdx.x * 512 + F.tid; i < (size_t)T * D / 4; i += (size_t)F.G * 512) { const f32x4 v = xs[i]; xo[i] = v; u32x2 w; w.x = cvt_pk_bf16(v.x, v.y); w.y = cvt_pk_bf16(v.z, v.w); xbo[i] = w; }
    const f32x4* ms = (const f32x4*)a.in[1]; u32x2* mo = (u32x2*)(F.ws + WS_KV + KV_MEMB);
    for (size_t i = (size_t)blockIdx.x * 512 + F.tid; i < (size_t)MROWS * D / 4; i += (size_t)F.G * 512) { const f32x4 v = ms[i]; u32x2 w; w.x = cvt_pk_bf16(v.x, v.y); w.y = cvt_pk_bf16(v.z, v.w); mo[i] = w; }
    bf16_t* wkv = (bf16_t*)(F.ws + WS_KV + KV_WKV);
    for (int l = 0; l < DEPTH; ++l) {
        transpose_all(F, a.in[23] + (size_t)l * D * D, D, D, wkv + (size_t)(2 * l) * D * D, 0, 0);
        transpose_all(F, a.in[24] + (size_t)l * D * D, D, D, wkv + (size_t)(2 * l + 1) * D * D, 0, 0);
    }
}

__device__ __forceinline__ void ssm_mats(Frame& F, const Args& a, int l, bf16_t* BT1, bf16_t* BT2) {
    LAS float* pwr = (LAS float*)F.lds;
    LAS float* pwi = pwr + 17 * 64;
    LAS float* bbr = pwi + 17 * 64;
    LAS float* bbi = bbr + 1024;
    LAS float* cr = bbi + 1024;
    LAS float* ci = cr + 1024;
    LAS float* km = ci + 1024;
    for (int g = blockIdx.x; g < NG; g += F.G) {
        __syncthreads();
        const float* are = a.in[5] + (size_t)(l * NG + g) * NP; const float* aim = a.in[6] + (size_t)(l * NG + g) * NP; const float dt = __expf(a.in[7][l * NG + g]);
        if (F.tid < NP) { const int p = F.tid; const float ar = are[p], ai = aim[p];
            const float mag = expf(ar * dt), ang = ai * dt, lr = mag * cosf(ang), li = mag * sinf(ang);
            float pr = 1.f, pi = 0.f;
            for (int k = 0; k <= 16; ++k) { pwr[k * 64 + p] = pr; pwi[k * 64 + p] = pi; const float nr = pr * lr - pi * li, ni = pr * li + pi * lr; pr = nr; pi = ni; }
            const float den = ar * ar + ai * ai, nre = lr - 1.f, fre = (nre * ar + li * ai) / den, fim = (li * ar - nre * ai) / den;
            const float* br = a.in[8] + ((size_t)(l * NG + g) * NP + p) * GC; const float* bi = a.in[9] + ((size_t)(l * NG + g) * NP + p) * GC;
            for (int c = 0; c < GC; ++c) { bbr[p * 16 + c] = fre * br[c] - fim * bi[c]; bbi[p * 16 + c] = fre * bi[c] + fim * br[c]; } }
        for (int i = F.tid; i < GC * NP; i += 512) { cr[i] = a.in[10][(size_t)(l * NG + g) * GC * NP + i]; ci[i] = a.in[11][(size_t)(l * NG + g) * GC * NP + i]; }
        __syncthreads();
        for (int o = F.tid; o < 4096; o += 512) { const int lag = o >> 8, c = (o >> 4) & 15, cp = o & 15; float s = 0.f;
            for (int p = 0; p < NP; ++p) { const float gr = cr[c * 64 + p] * pwr[lag * 64 + p] - ci[c * 64 + p] * pwi[lag * 64 + p], gi = cr[c * 64 + p] * pwi[lag * 64 + p] + ci[c * 64 + p] * pwr[lag * 64 + p];
                s += gr * bbr[p * 16 + cp] - gi * bbi[p * 16 + cp]; }
            km[o] = s; }
        __syncthreads();
        bf16_t* b2 = BT2 + (size_t)g * 256 * UCLD;
        for (int o = F.tid; o < 256 * UCLD / 2; o += 512) { const int n = o / (UCLD / 2), k2 = (o % (UCLD / 2)) * 2, t = n >> 4, c = n & 15; float v[2];
#pragma unroll
            for (int q = 0; q < 2; ++q) { const int k = k2 + q;
                if (k < 256) { const int s = k >> 4, cp = k & 15; v[q] = s <= t ? km[((t - s) << 8) + (c << 4) + cp] : 0.f; }
                else { const int p = (k - 256) & 63; const float gr = cr[c * 64 + p] * pwr[(t + 1) * 64 + p] - ci[c * 64 + p] * pwi[(t + 1) * 64 + p], gi = cr[c * 64 + p] * pwi[(t + 1) * 64 + p] + ci[c * 64 + p] * pwr[(t + 1) * 64 + p];
                    v[q] = k < 320 ? gr : -gi; } }
            *(unsigned*)(b2 + (size_t)n * UCLD + k2) = cvt_pk_bf16(v[0], v[1]); }
        bf16_t* b1 = BT1 + (size_t)g * 256 * 256;
        for (int o = F.tid; o < 256 * 128; o += 512) { const int n = o >> 7, k2 = (o & 127) * 2; float v[2];
#pragma unroll
            for (int q = 0; q < 2; ++q) { const int k = k2 + q, s = k >> 4, cp = k & 15;
                if (n < 128) { const int p = n & 63; const float lr = pwr[(15 - s) * 64 + p], li = pwi[(15 - s) * 64 + p];
                    v[q] = n < 64 ? (lr * bbr[p * 16 + cp] - li * bbi[p * 16 + cp]) : (lr * bbi[p * 16 + cp] + li * bbr[p * 16 + cp]); }
                else v[q] = 0.f; }
            *(unsigned*)(b1 + (size_t)n * 256 + k2) = cvt_pk_bf16(v[0], v[1]); }
    }
    __syncthreads();
}

__device__ __forceinline__ void prep_phase(Frame& F, const Args& a, int l) {
    unsigned char* wl = F.ws + WS_WL; unsigned char* fw = F.ws + WS_FFW;
    ssm_mats(F, a, l, (bf16_t*)(wl + WL_BT1), (bf16_t*)(wl + WL_BT2));
    transpose_all(F, a.in[4] + (size_t)l * D * INC, D, INC, (bf16_t*)(wl + WL_WIN), 0, 0);
    transpose_all(F, a.in[13] + (size_t)l * SSMW * SSMW, SSMW, SSMW, (bf16_t*)(wl + WL_WGLU), 0, 0);
    transpose_all(F, a.in[15] + (size_t)l * SSMW * D, SSMW, D, (bf16_t*)(wl + WL_WSUP), 0, 0);
    transpose_all(F, a.in[18] + (size_t)l * SSMW * D, SSMW, D, (bf16_t*)(wl + WL_WPUP), 0, 0);
    transpose_all(F, a.in[19] + (size_t)l * D * D, D, D, (bf16_t*)(wl + WL_WOUT), 0, 0);
    transpose_all(F, a.in[22] + (size_t)l * D * D, D, D, (bf16_t*)(wl + WL_WQ), 0, 0);
    transpose_all(F, a.in[25] + (size_t)l * D * D, D, D, (bf16_t*)(wl + WL_WO), 0, 0);
    { bf16_t* wp = (bf16_t*)(wl + WL_WPBD); const float* pw = a.in[16] + (size_t)l * 4 * 128 * 128; const float* ps = a.in[17] + (size_t)l * 512;
      for (size_t i = (size_t)blockIdx.x * 512 + F.tid; i < 512 * 512 / 2; i += (size_t)F.G * 512) { const int n = (int)(i >> 8), k = (int)(i & 255) * 2, gn = n >> 7, d = n & 127; float v0 = 0.f, v1 = 0.f;
          if ((k >> 7) == gn) { const float sc = ps[n]; v0 = pw[((size_t)gn * 128 + (k & 127)) * 128 + d] * sc; v1 = pw[((size_t)gn * 128 + ((k + 1) & 127)) * 128 + d] * sc; }
          *(unsigned*)(wp + (size_t)n * 512 + k) = cvt_pk_bf16(v0, v1); } }
    if ((l & 1) == 0) {
        const int li = l >> 1;
        transpose_all(F, a.in[28] + (size_t)li * D * FFD, D, FFD, (bf16_t*)(fw + FW_W13), 0, 1);
        transpose_all(F, a.in[29] + (size_t)li * D * FFD, D, FFD, (bf16_t*)(fw + FW_W13), 0, 2);
        transpose_all(F, a.in[30] + (size_t)li * FFD * D, FFD, D, (bf16_t*)(fw + FW_W2), 0, 0);
    } else {
        const int li = l >> 1;
        for (int e = 0; e < NE; ++e) {
            transpose_all(F, a.in[32] + ((size_t)li * NE + e) * D * FFE, D, FFE, (bf16_t*)(fw + FW_W13) + (size_t)e * 2 * FFE * D, 0, 1);
            transpose_all(F, a.in[33] + ((size_t)li * NE + e) * D * FFE, D, FFE, (bf16_t*)(fw + FW_W13) + (size_t)e * 2 * FFE * D, 0, 2);
            transpose_all(F, a.in[34] + ((size_t)li * NE + e) * FFE * D, FFE, D, (bf16_t*)(fw + FW_W2) + (size_t)e * D * FFE, 0, 0);
        }
    }
}

__device__ __forceinline__ void pool_phase(Frame& F, const bf16_t* up, bf16_t* pooled) {
    for (size_t it = (size_t)blockIdx.x * 512 + F.tid; it < (size_t)T * 64; it += (size_t)F.G * 512) {
        const int tok = (int)(it >> 6), cc = (int)(it & 63), win = 2 << (cc >> 4), pos = tok & (SEQ - 1), n = (pos + 1) < win ? (pos + 1) : win;
        const bf16_t* p = up + (size_t)tok * 512 + cc * 8;
        const u32x4 cur = *(const u32x4*)p; float s[8];
        s[0] = bf_lo(cur.x); s[1] = bf_hi(cur.x); s[2] = bf_lo(cur.y); s[3] = bf_hi(cur.y); s[4] = bf_lo(cur.z); s[5] = bf_hi(cur.z); s[6] = bf_lo(cur.w); s[7] = bf_hi(cur.w);
        float c0[8];
#pragma unroll
        for (int j = 0; j < 8; ++j) c0[j] = s[j];
        for (int q = 1; q < n; ++q) { const u32x4 w = *(const u32x4*)(p - (size_t)q * 512);
            s[0] += bf_lo(w.x); s[1] += bf_hi(w.x); s[2] += bf_lo(w.y); s[3] += bf_hi(w.y); s[4] += bf_lo(w.z); s[5] += bf_hi(w.z); s[6] += bf_lo(w.w); s[7] += bf_hi(w.w); }
        const float inv = 1.f / (float)n; u32x4 o;
        o.x = cvt_pk_bf16(s[0] * inv - c0[0], s[1] * inv - c0[1]); o.y = cvt_pk_bf16(s[2] * inv - c0[2], s[3] * inv - c0[3]);
        o.z = cvt_pk_bf16(s[4] * inv - c0[4], s[5] * inv - c0[5]); o.w = cvt_pk_bf16(s[6] * inv - c0[6], s[7] * inv - c0[7]);
        *(u32x4*)(pooled + (size_t)tok * 512 + cc * 8) = o;
    }
}

__device__ __forceinline__ void scan_phase(Frame& F, const Args& a, int l, const float* E, bf16_t* uc) {
    LAS float* ser = (LAS float*)F.lds;
    LAS float* sei = ser + 512;
    for (int bg = blockIdx.x; bg < NB * NG; bg += F.G) {
        const int b = bg / NG, g = bg % NG, p = F.tid & 63, seg = F.tid >> 6;
        __syncthreads();
        const float dt = __expf(a.in[7][l * NG + g]); const float ar = a.in[5][(size_t)(l * NG + g) * NP + p], ai = a.in[6][(size_t)(l * NG + g) * NP + p];
        const float mag = expf(ar * dt), ang = ai * dt; float lr = mag * cosf(ang), li = mag * sinf(ang);
#pragma unroll
        for (int q = 0; q < 4; ++q) { const float nr = lr * lr - li * li, ni = 2.f * lr * li; lr = nr; li = ni; }
        float er[32], ei[32];
        const float* Ep = E + ((size_t)g * CROWS + (size_t)b * NCH + seg * 32) * 128 + p;
#pragma unroll
        for (int j = 0; j < 32; ++j) { er[j] = Ep[(size_t)j * 128]; ei[j] = Ep[(size_t)j * 128 + 64]; }
        float hr = 0.f, hi = 0.f;
#pragma unroll
        for (int j = 0; j < 32; ++j) { const float nr = lr * hr - li * hi + er[j], ni = lr * hi + li * hr + ei[j]; hr = nr; hi = ni; }
        ser[seg * 64 + p] = hr; sei[seg * 64 + p] = hi;
        float Lr = lr, Li = li;
#pragma unroll
        for (int q = 0; q < 5; ++q) { const float nr = Lr * Lr - Li * Li, ni = 2.f * Lr * Li; Lr = nr; Li = ni; }
        __syncthreads();
        hr = 0.f; hi = 0.f;
        for (int s = 0; s < seg; ++s) { const float nr = Lr * hr - Li * hi + ser[s * 64 + p], ni = Lr * hi + Li * hr + sei[s * 64 + p]; hr = nr; hi = ni; }
        bf16_t* up = uc + ((size_t)g * CROWS + (size_t)b * NCH + seg * 32) * UCLD + 256 + p;
#pragma unroll
        for (int j = 0; j < 32; ++j) { up[(size_t)j * UCLD] = (bf16_t)(cvt_pk_bf16(hr, 0.f) & 0xffffu); up[(size_t)j * UCLD + 64] = (bf16_t)(cvt_pk_bf16(hi, 0.f) & 0xffffu);
            const float nr = lr * hr - li * hi + er[j], ni = lr * hi + li * hr + ei[j]; hr = nr; hi = ni; }
    }
}

#ifndef MK_ONLY
#define MK_ONLY -1
#endif
__global__ void __launch_bounds__(NWAVES * 64, 2) fwd_kernel(Args args) {
    extern __shared__ __attribute__((aligned(16))) unsigned char lds_raw[];
    Frame F;
    F.lds = (LAS unsigned char*)lds_raw;
    F.MISC = (volatile LAS unsigned*)(F.lds + MISC_OFF);
    F.G = gridDim.x; F.NGW = F.G * NWAVES; F.tid = 0; F.lane = 0; F.wave = 0; F.gw = 0;
    if (threadIdx.x < 32) F.MISC[threadIdx.x] = 0u;
    __syncthreads();
    XcdBarrier bar = xcd_barrier_post((unsigned*)(args.ws + WS_CTL) + CW_BAR, F.MISC + 8);
    const int lo = args.ph_lo, hi = args.ph_hi; int gp = 0;
    LAS unsigned char* ring = F.lds; LAS unsigned char* xl = F.lds + XL_OFF;
    const int c0_ = (int)blockIdx.x, G0_ = (int)gridDim.x;
    const int vc0_ = (G0_ % 8 == 0) ? (c0_ % 8) * (G0_ / 8) + c0_ / 8 : c0_;
#define PHASE_BEGIN(id) if ((MK_ONLY < 0 || MK_ONLY == (id)) && gp >= lo && gp < hi) { \
        GU8* wsp1 = (GU8*)args.ws; GF32* outp1 = (GF32*)args.out; int c = c0_, vc = vc0_, G = G0_; asm volatile("" : "+s"(wsp1), "+s"(outp1), "+s"(c), "+s"(vc), "+s"(G)); int t_ = threadIdx.x; asm volatile("" : "+v"(t_)); \
        unsigned char* wsp = (unsigned char*)wsp1; float* outp = (float*)outp1; \
        F.ws = wsp; F.ctl = (unsigned*)(wsp + WS_CTL); F.x = outp; F.xb = (bf16_t*)(wsp + WS_XB); F.tid = t_; F.lane = t_ & 63; F.wave = __builtin_amdgcn_readfirstlane(t_ >> 6); F.G = G; F.NGW = G * NWAVES; F.gw = c * NWAVES + F.wave; \
        unsigned char* const wl = wsp + WS_WL; unsigned char* const act = wsp + WS_ACT; unsigned char* const fw = wsp + WS_FFW; unsigned char* const kv = wsp + WS_KV; (void)wl; (void)act; (void)fw; (void)kv;
#define PHASE_END if (gp + 1 < hi) xcd_barrier(bar); } ++gp;
#define BF(p) ((bf16_t*)(p))
#define CBF(p) ((const bf16_t*)(p))

    PHASE_BEGIN(0) init_phase(F, args); PHASE_END
    PHASE_BEGIN(1) { pg8::SchedKv S{CBF(kv + KV_WKV), CBF(kv + KV_MEMB), D, D, D, G, c}; pg8::EpiKv E{BF(kv + KV_MATS)}; pg8::gemm_phase(ring, xl, S, E); } PHASE_END

#pragma unroll 1
    for (int l = 0; l < DEPTH; ++l) {
        PHASE_BEGIN(2) prep_phase(F, args, l); PHASE_END
        PHASE_BEGIN(3) { pg8::SchedPlain S{F.xb, CBF(wl + WL_WIN), D, D, D, T / 256, INC / 256, G, c}; pg8::EpiProj E{BF(act + A_UC), BF(act + A_UPOOL), BF(act + A_GATES)}; pg8::gemm_phase(ring, xl, S, E); } PHASE_END
        PHASE_BEGIN(4) { pg8::SchedSsm S{CBF(act + A_UC), CBF(wl + WL_BT1), UCLD, 256, 256, G, vc}; pg8::EpiSsmE E{(float*)(act + A_EBUF)}; pg8::gemm_phase(ring, xl, S, E);
                         pool_phase(F, CBF(act + A_UPOOL), BF(act + A_POOLED)); } PHASE_END
        PHASE_BEGIN(5) scan_phase(F, args, l, (const float*)(act + A_EBUF), BF(act + A_UC)); PHASE_END
        PHASE_BEGIN(6) { pg8::SchedSsm S{CBF(act + A_UC), CBF(wl + WL_BT2), UCLD, UCLD, UCLD, G, vc}; pg8::EpiSsmY E{CBF(act + A_UC), args.in[12] + (size_t)l * SSMW, BF(act + A_YSG)}; pg8::gemm_phase(ring, xl, S, E); }
                       { pg8::SchedPlain S{CBF(act + A_POOLED), CBF(wl + WL_WPBD), 512, 512, 512, T / 256, 2, G, c}; pg8::EpiBf16 E{BF(act + A_POOLOUT), 512, 1.0f, 0}; pg8::gemm_phase(ring, xl, S, E); } PHASE_END
        PHASE_BEGIN(7) { pg8::SchedPlain S{CBF(act + A_YSG), CBF(wl + WL_WGLU), 512, 512, 512, T / 256, 2, G, c}; pg8::EpiGlu E{CBF(act + A_YSG), args.in[14] + (size_t)l * SSMW, BF(act + A_SSMOUT)}; pg8::gemm_phase(ring, xl, S, E); } PHASE_END
        PHASE_BEGIN(8) { pg8::SchedPlain S{CBF(act + A_SSMOUT), CBF(wl + WL_WSUP), 512, 512, 512, T / 256, 4, G, c}; pg8::EpiUp<false> E{CBF(act + A_GATES), BF(act + A_INNER)}; pg8::gemm_phase(ring, xl, S, E); }
                       { pg8::SchedPlain S{CBF(act + A_POOLOUT), CBF(wl + WL_WPUP), 512, 512, 512, T / 256, 4, G, c}; pg8::EpiUp<true> E{CBF(act + A_GATES) + 1024, BF(act + A_INNER)}; pg8::gemm_phase(ring, xl, S, E); } PHASE_END
        PHASE_BEGIN(9) { pg8::SchedPlain S{CBF(act + A_INNER), CBF(wl + WL_WOUT), D, D, D, T / 256, 4, G, c}; pg8::EpiRes E{F.x}; pg8::gemm_phase(ring, xl, S, E); } PHASE_END
        PHASE_BEGIN(10) ln_phase<0>(F, args.in[2] + (size_t)l * D, args.in[3] + (size_t)l * D, nullptr, nullptr, nullptr, nullptr); PHASE_END
        PHASE_BEGIN(11) { pg8::SchedPlain S{F.xb, CBF(wl + WL_WQ), D, D, D, T / 256, 4, G, c}; pg8::EpiBf16 E{BF(act + A_Q), D, 0.0625f, 0}; pg8::gemm_phase(ring, xl, S, E); } PHASE_END
        PHASE_BEGIN(12) { pg8::SchedAttn S{CBF(act + A_Q), CBF(kv + KV_MATS) + (size_t)l * (2 * MROWS * D), D, D, HD, G, vc, 0}; pg8::EpiSoftmax E{BF(act + A_P)}; pg8::gemm_phase(ring, xl, S, E); } PHASE_END
        PHASE_BEGIN(13) { pg8::SchedAttn S{CBF(act + A_P), CBF(kv + KV_MATS) + (size_t)l * (2 * MROWS * D) + (size_t)MROWS * D, D, MROWS, NMEM, G, vc, 1}; pg8::EpiBf16 E{BF(act + A_AO), D, 1.0f, 0}; pg8::gemm_phase(ring, xl, S, E); } PHASE_END
        PHASE_BEGIN(14) { pg8::SchedPlain S{CBF(act + A_AO), CBF(wl + WL_WO), D, D, D, T / 256, 4, G, c}; pg8::EpiRes E{F.x}; pg8::gemm_phase(ring, xl, S, E); } PHASE_END
        if ((l & 1) == 0) {
            PHASE_BEGIN(15) ln_phase<0>(F, args.in[20] + (size_t)l * D, args.in[21] + (size_t)l * D, nullptr, nullptr, nullptr, nullptr); PHASE_END
            PHASE_BEGIN(16) { pg8::SchedPlain S{F.xb, CBF(fw + FW_W13), D, D, D, T / 256, 2 * FFD / 256, G, c}; pg8::EpiSwiglu E{BF(act + A_H), FFD}; pg8::gemm_phase(ring, xl, S, E); } PHASE_END
            PHASE_BEGIN(17) { pg8::SchedPlain S{CBF(act + A_H), CBF(fw + FW_W2), FFD, FFD, FFD, T / 256, 4, G, c}; pg8::EpiRes E{F.x}; pg8::gemm_phase(ring, xl, S, E); } PHASE_END
            PHASE_BEGIN(18) ln_phase<0>(F, args.in[26] + (size_t)l * D, args.in[27] + (size_t)l * D, nullptr, nullptr, nullptr, nullptr); PHASE_END
        } else {
            PHASE_BEGIN(19) ln_phase<1>(F, args.in[20] + (size_t)l * D, args.in[21] + (size_t)l * D, args.in[31] + (size_t)(l >> 1) * D * NE, (uint4*)(act + A_TOKINFO), nullptr, nullptr); PHASE_END
            PHASE_BEGIN(20) moe_gather_phase(F, (const uint4*)(act + A_TOKINFO), (uint2*)(act + A_TOKPOS), BF(act + A_XS)); PHASE_END
            PHASE_BEGIN(21) { const int ntl = (int)F.ctl[CW_META]; pg8::SchedMoe S{CBF(act + A_XS), CBF(fw + FW_W13), F.ctl + CW_META, D, D, D, ntl, 2 * FFE / 256, G, c}; pg8::EpiSwiglu E{BF(act + A_HM), FFE}; pg8::gemm_phase(ring, xl, S, E); } PHASE_END
            PHASE_BEGIN(22) { const int ntl = (int)F.ctl[CW_META]; pg8::SchedMoe S{CBF(act + A_HM), CBF(fw + FW_W2), F.ctl + CW_META, FFE, FFE, FFE, ntl, 4, G, c}; pg8::EpiBf16 E{BF(act + A_Y), D, 1.0f, 0}; pg8::gemm_phase(ring, xl, S, E); } PHASE_END
            PHASE_BEGIN(23) ln_phase<2>(F, args.in[26] + (size_t)l * D, args.in[27] + (size_t)l * D, nullptr, (uint4*)(act + A_TOKINFO), (const uint2*)(act + A_TOKPOS), CBF(act + A_Y)); PHASE_END
        }
    }
#undef PHASE_BEGIN
#undef PHASE_END
}
constexpr int N_PHASES = 2 + 2 * (13 + 4) + 2 * (13 + 5);


#ifndef MK_DUMP_OFF
#define MK_DUMP_OFF (WS_WL + WL_WSUP)
#define MK_DUMP_OFF2 (WS_ACT + A_GATES)
#endif
#ifndef MK_DUMP_KIND
#define MK_DUMP_KIND 0
#endif
#ifndef MK_DUMP_N
#define MK_DUMP_N (0)
#endif
__global__ void dump_kernel(const unsigned char* ws, float* out) {
    for (size_t i = (size_t)blockIdx.x * blockDim.x + threadIdx.x; i < (size_t)T * D; i += (size_t)gridDim.x * blockDim.x) {
        float v = 0.f;
        if (i < (size_t)MK_DUMP_N) { if (MK_DUMP_KIND == 1) v = __uint_as_float((unsigned)((const bf16_t*)(ws + MK_DUMP_OFF))[i] << 16); else v = ((const float*)(ws + MK_DUMP_OFF))[i]; }
        else if (MK_DUMP_KIND == 1) v = __uint_as_float((unsigned)((const bf16_t*)(ws + MK_DUMP_OFF2))[i - MK_DUMP_N] << 16);
        out[i] = v; }
}
extern "C" void kernel_launch(void* const* d_in, const int* in_sizes, int n_in, void* d_out, int out_size, void* d_ws, size_t ws_size, hipStream_t stream) {
    static int grid = 0;
    if (grid == 0) {
        if (n_in != 35 || in_sizes[0] != T * D || out_size != T * D || ws_size < WS_END) { fprintf(stderr, "kernel_launch: unexpected problem (n_in %d, in0 %d, out %d, ws %zu, need %zu); nothing launched\n", n_in, n_in > 0 ? in_sizes[0] : -1, out_size, ws_size, (size_t)WS_END); grid = -1; return; }
        int dev = 0, cus = 0, per_cu = 0;
        if (hipGetDevice(&dev) != hipSuccess || hipDeviceGetAttribute(&cus, hipDeviceAttributeMultiprocessorCount, dev) != hipSuccess) { grid = -1; return; }
        if (hipFuncSetAttribute((const void*)fwd_kernel, hipFuncAttributeMaxDynamicSharedMemorySize, LDS_BYTES) != hipSuccess) { fprintf(stderr, "kernel_launch: hipFuncSetAttribute failed\n"); grid = -1; return; }
        if (hipOccupancyMaxActiveBlocksPerMultiprocessor(&per_cu, (const void*)fwd_kernel, NWAVES * 64, LDS_BYTES) != hipSuccess || per_cu < 1) fprintf(stderr, "kernel_launch: occupancy query reports %d\n", per_cu);
        (void)hipGetLastError();
        grid = cus;
    }
    if (grid < 0) return;
    if (hipMemsetAsync((char*)d_ws + WS_CTL, 0, CTL_ZERO_BYTES, stream) != hipSuccess) return;
    Args a{};
    for (int i = 0; i < 35; ++i) a.in[i] = (const float*)d_in[i];
    a.out = (float*)d_out; a.ws = (unsigned char*)d_ws;
#if MK_PER_PHASE
    for (int p = 0; p < (MK_PMAX < N_PHASES ? MK_PMAX : N_PHASES); ++p) { a.ph_lo = p; a.ph_hi = p + 1; hipLaunchKernelGGL(fwd_kernel, dim3(grid), dim3(NWAVES * 64), LDS_BYTES, stream, a); }
    if (MK_DUMP_KIND) hipLaunchKernelGGL(dump_kernel, dim3(2048), dim3(256), 0, stream, (const unsigned char*)d_ws, (float*)d_out);
#else
    a.ph_lo = 0; a.ph_hi = N_PHASES;
    hipLaunchKernelGGL(fwd_kernel, dim3(grid), dim3(NWAVES * 64), LDS_BYTES, stream, a);
#endif
}
```

```cpp
#include <hip/hip_runtime.h>
#include <cstdio>
#include <cstdint>

#ifndef MK_PER_PHASE
#define MK_PER_PHASE 0
#endif
#ifndef MK_PMAX
#define MK_PMAX 1000
#endif
#ifndef MK_DIRECT
#define MK_DIRECT 0
#endif

#define LAS __attribute__((address_space(3)))
typedef unsigned short bf16_t;
typedef short bf16x8 __attribute__((ext_vector_type(8)));
typedef float f32x4 __attribute__((ext_vector_type(4)));
typedef float f32x2 __attribute__((ext_vector_type(2)));
typedef unsigned u32x4 __attribute__((ext_vector_type(4)));
typedef unsigned u32x2 __attribute__((ext_vector_type(2)));
typedef __attribute__((address_space(1))) unsigned char GU8;
typedef __attribute__((address_space(1))) float GF32;

constexpr int NB = 8, SEQ = 4096, D = 1024, T = NB * SEQ, DEPTH = 4;
constexpr int NMEM = 256, MROWS = NB * NMEM;
constexpr int SSMW = 512, NG = 32, GC = 16, NP = 64;
constexpr int INC = 3072;
constexpr int NH = 4, HD = 256;
constexpr int FFD = 2816, NE = 8, FFE = 3584;
constexpr int CH = 16;
constexpr int NCH = SEQ / CH;
constexpr int CROWS = T / CH;
constexpr int UCLD = 384;
constexpr float ALPHA = 1.6817928305074290f;
constexpr float LN_EPS = 1e-5f;
constexpr int MOE_ROWS = 2 * T + NE * 256;

constexpr size_t MiB = 1u << 20;
constexpr size_t WS_CTL = 0, CTL_ZERO_BYTES = 1 * MiB;
constexpr size_t WS_XB = 1 * MiB;
constexpr size_t WS_WL = WS_XB + 64 * MiB;
constexpr size_t  WL_WIN = 0, WL_WGLU = 6 * MiB, WL_WPBD = WL_WGLU + MiB / 2, WL_WSUP = 7 * MiB, WL_WPUP = 8 * MiB, WL_WOUT = 9 * MiB,
                  WL_WQ = 11 * MiB, WL_WO = 13 * MiB, WL_BT1 = 15 * MiB, WL_BT2 = 19 * MiB, WL_END = 25 * MiB;
constexpr size_t WS_KV = WS_WL + 32 * MiB;
constexpr size_t  KV_WKV = 0, KV_MATS = 16 * MiB, KV_MEMB = 48 * MiB;
constexpr size_t WS_FFW = WS_KV + 56 * MiB;
constexpr size_t  FW_W13 = 0, FW_W2 = 112 * MiB;
constexpr size_t WS_ACT = WS_FFW + 168 * MiB;
constexpr size_t  A_UC = 0, A_UPOOL = 48 * MiB, A_GATES = 80 * MiB, A_EBUF = 208 * MiB, A_YSG = 240 * MiB, A_POOLED = 272 * MiB, A_POOLOUT = 304 * MiB,
                  A_SSMOUT = 336 * MiB, A_INNER = 368 * MiB, A_MIX_END = 432 * MiB;
constexpr size_t  A_Q = 0, A_P = 64 * MiB, A_AO = 128 * MiB;
constexpr size_t  A_H = 0;
constexpr size_t  A_TOKINFO = 0, A_TOKPOS = 1 * MiB, A_XS = 2 * MiB, A_Y = 2 * MiB, A_HM = 136 * MiB, A_MOE_END = A_HM + (size_t)MOE_ROWS * FFE * 2;
constexpr size_t WS_END = WS_ACT + ((A_MOE_END + MiB - 1) / MiB) * MiB;
static_assert((size_t)MOE_ROWS * D * 2 <= 134 * MiB, "XS/Y size");
static_assert(A_MOE_END >= A_MIX_END, "union");

constexpr int CW_BAR = 4096;
constexpr int CW_WGHIST = 16384;
constexpr int CW_META = 32768;

constexpr int RING_BYTES = 131072;
constexpr int XL_OFF = RING_BYTES;
constexpr int MISC_OFF = XL_OFF + 8192;
constexpr int LDS_BYTES = 147456;

#define XB_TMO      128
#define XB_XCNT(j)  (256  + 64 * (j))
#define XB_XSUB(j)  (1280 + 64 * (j))
#define XB_XGEN(j)  (2304 + 64 * (j))
#define XB_TOP      3328
#define XB_TOPGEN   3392
#define XCD_BAR_WORDS 3456
#define XB_SPIN_CAP (1u << 18)
__device__ __forceinline__ unsigned xb_ld(unsigned* p)              { return __hip_atomic_load(p, __ATOMIC_RELAXED, __HIP_MEMORY_SCOPE_AGENT); }
__device__ __forceinline__ unsigned xb_add(unsigned* p, unsigned v) { return __hip_atomic_fetch_add(p, v, __ATOMIC_RELAXED, __HIP_MEMORY_SCOPE_AGENT); }
__device__ __forceinline__ unsigned xb_xcc_id() { return (unsigned)__builtin_amdgcn_s_getreg((3 << 11) | 20) & 0xFu; }
#define XB_SPIN(cond, bar) do { unsigned _sp = 0; while (cond) { __builtin_amdgcn_s_sleep(1); \
    if ((++_sp & 255u) == 0u) { if (xb_ld(&(bar)[XB_TMO])) break; if (_sp > XB_SPIN_CAP) { atomicAdd(&(bar)[XB_TMO], 1u); break; } } } } while (0)
struct XcdBarrier { unsigned* bar; unsigned x; volatile LAS unsigned* st; };
__device__ __forceinline__ XcdBarrier xcd_barrier_post(unsigned* bar, volatile LAS unsigned* st) {
    XcdBarrier b; b.bar = bar; b.x = xb_xcc_id(); b.st = st;
    if (threadIdx.x == 0) (void)xb_add(&bar[XB_XCNT(b.x)], 1u);
    return b;
}
__device__ __forceinline__ void xcd_barrier_complete(unsigned* bar, unsigned x, unsigned& nloc, unsigned& nx) {
    const unsigned G = gridDim.x * gridDim.y * gridDim.z;
    unsigned sum, cnt, mine, sp = 0u;
    for (;;) {
        sum = 0u; cnt = 0u; mine = 0u;
#pragma unroll
        for (unsigned j = 0; j < 16; ++j) { const unsigned c = xb_ld(&bar[XB_XCNT(j)]); sum += c; cnt += (c > 0u) ? 1u : 0u; mine = (j == x) ? c : mine; }
        if (sum == G) break;
        __builtin_amdgcn_s_sleep(1);
        if ((++sp & 255u) == 0u) { if (xb_ld(&bar[XB_TMO])) break; if (sp > XB_SPIN_CAP) { atomicAdd(&bar[XB_TMO], 1u); break; } }
    }
    nloc = mine > 0u ? mine : 1u; nx = cnt > 0u ? cnt : 1u;
}
__device__ __forceinline__ void xcd_barrier(const XcdBarrier& b) {
    asm volatile("s_waitcnt vmcnt(0)" ::: "memory");
    __syncthreads();
    if (threadIdx.x == 0) {
        unsigned* bar = b.bar;
        __builtin_amdgcn_s_waitcnt(0);
        unsigned nloc = b.st[0], nx = b.st[1];
        if (nloc == 0u) { xcd_barrier_complete(bar, b.x, nloc, nx); b.st[0] = nloc; b.st[1] = nx; }
        const unsigned old = xb_add(&bar[XB_XSUB(b.x)], 1u);
        const unsigned gen = old / nloc;
        if (old + 1u == (gen + 1u) * nloc) {
            __builtin_amdgcn_fence(__ATOMIC_RELEASE, "agent");
            asm volatile("s_waitcnt vmcnt(0)" ::: "memory");
            const unsigned og = xb_add(&bar[XB_TOP], 1u);
            const unsigned tg = og / nx;
            if (og + 1u == (tg + 1u) * nx) xb_add(&bar[XB_TOPGEN], 1u);
            else XB_SPIN(xb_ld(&bar[XB_TOPGEN]) == tg, bar);
            __builtin_amdgcn_fence(__ATOMIC_ACQUIRE, "agent");
            xb_add(&bar[XB_XGEN(b.x)], 1u);
            asm volatile("s_waitcnt vmcnt(0)" ::: "memory");
        } else {
            XB_SPIN(xb_ld(&bar[XB_XGEN(b.x)]) == gen, bar);
            __builtin_amdgcn_fence(__ATOMIC_ACQUIRE, "agent");
            asm volatile("s_waitcnt vmcnt(0)" ::: "memory");
        }
    }
    __syncthreads();
}

typedef __bf16 bf16x2_t __attribute__((ext_vector_type(2)));
__device__ __forceinline__ unsigned cvt_pk_bf16(float lo, float hi) { const f32x2 v = {lo, hi}; const bf16x2_t b = __builtin_convertvector(v, bf16x2_t); return __builtin_bit_cast(unsigned, b); }
__device__ __forceinline__ float bf_lo(unsigned w) { return __uint_as_float(w << 16); }
__device__ __forceinline__ float bf_hi(unsigned w) { return __uint_as_float(w & 0xffff0000u); }
__device__ __forceinline__ float fast_sigmoid(float x) { return __builtin_amdgcn_rcpf(1.0f + __builtin_amdgcn_exp2f(-1.4426950408889634f * x)); }
__device__ __forceinline__ float gelu_tanh(float x) { const float u = 0.7978845608028654f * (x + 0.044715f * x * x * x); return x * fast_sigmoid(2.0f * u); }
__device__ __forceinline__ float wave_sum(float v) {
#pragma unroll
    for (int o = 1; o < 64; o <<= 1) v += __shfl_xor(v, o);
    return v;
}
__device__ __forceinline__ int wave_sum_i(int v) {
#pragma unroll
    for (int o = 1; o < 64; o <<= 1) v += __shfl_xor(v, o);
    return v;
}
#define LDS_WAIT() asm volatile("s_waitcnt lgkmcnt(0)" ::: "memory")
#define VM_WAIT() asm volatile("s_waitcnt vmcnt(0)" ::: "memory")

namespace pg8 {
constexpr int BM = 256, BK = 64, HALF = 128, HTB = HALF * BK * 2, STAGE_BYTES = 8 * HTB, NXCD = 8, WGM = 8;
__host__ __device__ __forceinline__ int lds_byte(int r, int c) { const int st = (r >> 4) * 2 + (c >> 5), rr = r & 15, cc = c & 31, ob = rr * 64 + cc * 2; return st * 1024 + (ob ^ (((ob >> 9) & 1) << 5)); }
__host__ __device__ __forceinline__ void stage_rc(int b, int& R, int& C) { const int st = b / 1024, sb = b % 1024, swz = sb ^ (((sb >> 9) & 1) << 5); R = (st >> 1) * 16 + swz / 64; C = (st & 1) * 32 + (swz % 64) / 2; }
__host__ __device__ __forceinline__ int perm32(int rho) { const int n = rho >> 4, i = rho & 15; return 8 * (i >> 2) + 4 * n + (i & 3); }

struct Unit { int pm, pn, g; };

__device__ __forceinline__ bool static_order(long L, int nM, int nN, Unit& u) {
    const int nwg = nM * nN; if (L >= nwg) return false;
    int wgid = (int)L; { const int q = nwg / NXCD, r = nwg % NXCD, xcd = wgid % NXCD, off = wgid / NXCD; wgid = (xcd < r ? xcd * (q + 1) : r * (q + 1) + (xcd - r) * q) + off; }
    const int nig = WGM * nN, gid = wgid / nig, fm = gid * WGM, gsz = (nM - fm) < WGM ? (nM - fm) : WGM;
    u.pm = fm + ((wgid % nig) % gsz); u.pn = (wgid % nig) / gsz; u.g = 0; return true;
}

#if !MK_DIRECT
template <class Epi, class Sched>
__device__ __forceinline__ void gemm_phase(LAS unsigned char* lds, LAS unsigned char* xl, const Sched& S, const Epi& E) {
    int tid_ = threadIdx.x; asm volatile("" : "+v"(tid_));
    const int tid = tid_, wid = __builtin_amdgcn_readfirstlane(tid >> 6), lane = tid & 63, wr = wid >> 2, wc = wid & 3, fr = lane & 15, fq = lane >> 4;
    const int K = S.K, nt = K / BK, lda = S.lda, ldb = S.ldb;
    unsigned voffA[2], voffB[2];
#pragma unroll
    for (int i = 0; i < 2; ++i) { int R, C; stage_rc(tid * 16 + i * 8192, R, C); const int Rb = Epi::PERM ? ((R & ~31) + perm32(R & 31)) : R;
        voffA[i] = (unsigned)(R * lda + C) * 2u; voffB[i] = (unsigned)(Rb * ldb + C) * 2u; }
    const size_t kstep = (size_t)(BK * 2);
    const size_t hstepA = (size_t)HALF * lda * 2, hstepB = (size_t)HALF * ldb * 2;
    const unsigned ldsw = (unsigned)wid * 1024u;
    const int aoff = lds_byte(wr * 64 + fr, fq * 8), boff = lds_byte(wc * 32 + fr, fq * 8);
#define PG8_SA(b, h) (((b) * 2 + (h)) * HTB)
#define PG8_SB(b, h) ((4 + (b) * 2 + (h)) * HTB)
#define PG8_STAGE(bufoff, gbase, voff) do { _Pragma("unroll") for (int _i = 0; _i < 2; ++_i) \
        __builtin_amdgcn_global_load_lds((const unsigned*)((const char*)(gbase) + (voff)[_i]), (LAS unsigned*)(lds + (bufoff) + ldsw + _i * 8192), 16, 0, 0); } while (0)
#define PG8_LDA(dst, b, h) do { _Pragma("unroll") for (int m = 0; m < 4; ++m) _Pragma("unroll") for (int k = 0; k < 2; ++k) dst[m][k] = *(const LAS bf16x8*)(lds + PG8_SA(b, h) + aoff + m * 2048 + k * 1024); } while (0)
#define PG8_LDB(dst, b, h) do { _Pragma("unroll") for (int n = 0; n < 2; ++n) _Pragma("unroll") for (int k = 0; k < 2; ++k) dst[n][k] = *(const LAS bf16x8*)(lds + PG8_SB(b, h) + boff + n * 2048 + k * 1024); } while (0)
#define PG8_MMA(ai, bj, At, Bt) do { __builtin_amdgcn_s_setprio(1); _Pragma("unroll") for (int m = 0; m < 4; ++m) _Pragma("unroll") for (int n = 0; n < 2; ++n) _Pragma("unroll") for (int k = 0; k < 2; ++k) \
        acc[ai][bj][m][n] = __builtin_amdgcn_mfma_f32_16x16x32_bf16(Bt[n][k], At[m][k], acc[ai][bj][m][n], 0, 0, 0); __builtin_amdgcn_s_setprio(0); } while (0)
#define PG8_WAIT_V(n) asm volatile("s_waitcnt vmcnt(" #n ")" ::: "memory")
#define PG8_WAIT_L(n) asm volatile("s_waitcnt lgkmcnt(" #n ")" ::: "memory")
#define PG8_BAR __builtin_amdgcn_s_barrier()
#define PG8_SCHED __builtin_amdgcn_sched_barrier(0)
    Unit cur, nxt; int ui = 0;
    if (!S.next(0, cur)) return;
    f32x4 acc[2][2][4][2];
#pragma unroll
    for (int a = 0; a < 2; ++a)
#pragma unroll
        for (int b = 0; b < 2; ++b)
#pragma unroll
            for (int m = 0; m < 4; ++m)
#pragma unroll
                for (int n = 0; n < 2; ++n) acc[a][b][m][n] = (f32x4){0.f, 0.f, 0.f, 0.f};
    bf16x8 At[4][2], B0[2][2], B1[2][2];
    const char* cA = S.a_tile(cur); const char* cB = S.b_tile(cur);
    PG8_STAGE(PG8_SB(0, 0), cB, voffB); PG8_STAGE(PG8_SB(0, 1), cB + hstepB, voffB); PG8_STAGE(PG8_SA(0, 0), cA, voffA); PG8_STAGE(PG8_SA(0, 1), cA + hstepA, voffA);
    if (wr == 1) PG8_BAR;
    PG8_WAIT_V(2); PG8_BAR;
    PG8_STAGE(PG8_SB(1, 0), cB + kstep, voffB); PG8_STAGE(PG8_SA(1, 0), cA + kstep, voffA); PG8_STAGE(PG8_SB(1, 1), cB + hstepB + kstep, voffB);
    PG8_WAIT_V(6); PG8_BAR;
    for (;;) {
        const bool has_next = S.next(ui + 1, nxt);
        const char* nA = has_next ? S.a_tile(nxt) : cA; const char* nB = has_next ? S.b_tile(nxt) : cB;
        for (int t = 0; t < nt; t += 2) {
            const bool last = (t == nt - 2);
            const char* a1 = cA + (size_t)(t + 1) * kstep;
            const char* a2 = last ? nA : cA + (size_t)(t + 2) * kstep; const char* b2 = last ? nB : cB + (size_t)(t + 2) * kstep;
            const char* a3 = a2 + kstep; const char* b3 = b2 + kstep;
            PG8_LDB(B0, 0, 0); PG8_LDB(B1, 0, 1); PG8_SCHED; PG8_LDA(At, 0, 0); PG8_STAGE(PG8_SA(1, 1), a1 + hstepA, voffA);
            PG8_WAIT_V(8); PG8_WAIT_L(0); PG8_BAR; PG8_MMA(0, 0, At, B0); PG8_MMA(0, 1, At, B1); PG8_BAR; PG8_SCHED;
            PG8_LDA(At, 0, 1); PG8_STAGE(PG8_SB(0, 0), b2, voffB); PG8_STAGE(PG8_SB(0, 1), b2 + hstepB, voffB); PG8_STAGE(PG8_SA(0, 0), a2, voffA);
            PG8_WAIT_V(8); PG8_WAIT_L(0); PG8_BAR; PG8_MMA(1, 0, At, B0); PG8_MMA(1, 1, At, B1); PG8_BAR; PG8_SCHED;
            PG8_LDB(B0, 1, 0); PG8_LDB(B1, 1, 1); PG8_SCHED; PG8_LDA(At, 1, 0); PG8_STAGE(PG8_SA(0, 1), a2 + hstepA, voffA);
            PG8_WAIT_V(8); PG8_WAIT_L(0); PG8_BAR; PG8_MMA(0, 0, At, B0); PG8_MMA(0, 1, At, B1); PG8_BAR; PG8_SCHED;
            PG8_LDA(At, 1, 1); PG8_STAGE(PG8_SB(1, 0), b3, voffB); PG8_STAGE(PG8_SB(1, 1), b3 + hstepB, voffB); PG8_STAGE(PG8_SA(1, 0), a3, voffA);
            PG8_WAIT_V(8); PG8_WAIT_L(0); PG8_BAR; PG8_MMA(1, 0, At, B0); PG8_MMA(1, 1, At, B1); PG8_BAR; PG8_SCHED;
        }
        if (wr == 0) PG8_BAR;
        { int fr2 = fr, fq2 = fq; asm volatile("" : "+v"(fr2), "+v"(fq2));
          E(acc, cur, wr, wc, fr2, fq2, xl); }
        if (!has_next) break;
#pragma unroll
        for (int a = 0; a < 2; ++a)
#pragma unroll
            for (int b = 0; b < 2; ++b)
#pragma unroll
                for (int m = 0; m < 4; ++m)
#pragma unroll
                    for (int n = 0; n < 2; ++n) acc[a][b][m][n] = (f32x4){0.f, 0.f, 0.f, 0.f};
        cur = nxt; cA = nA; cB = nB; ++ui;
        if (wr == 1) PG8_BAR;
    }
    PG8_WAIT_V(0);
    PG8_BAR;
#undef PG8_SA
#undef PG8_SB
#undef PG8_STAGE
#undef PG8_LDA
#undef PG8_LDB
#undef PG8_MMA
#undef PG8_WAIT_V
#undef PG8_WAIT_L
#undef PG8_BAR
#undef PG8_SCHED
}
#else
template <class Epi, class Sched>
__device__ __forceinline__ void gemm_phase(LAS unsigned char* lds, LAS unsigned char* xl, const Sched& S, const Epi& E) {
    int tid_ = threadIdx.x; asm volatile("" : "+v"(tid_));
    const int tid = tid_, wid = __builtin_amdgcn_readfirstlane(tid >> 6), lane = tid & 63, wr = wid >> 2, wc = wid & 3, fr = lane & 15, fq = lane >> 4;
    const int K = S.K, nt = K / BK, lda = S.lda, ldb = S.ldb;
    unsigned offA[4], offB[2];
#pragma unroll
    for (int m = 0; m < 4; ++m) offA[m] = (unsigned)((64 * wr + 16 * m + fr) * lda + fq * 8) * 2u;
#pragma unroll
    for (int n = 0; n < 2; ++n) offB[n] = (unsigned)((32 * wc + (Epi::PERM ? perm32(16 * n + fr) : (16 * n + fr))) * ldb + fq * 8) * 2u;
    Unit cur;
    for (int ui = 0; S.next(ui, cur); ++ui) {
        f32x4 acc[2][2][4][2];
#pragma unroll
        for (int a = 0; a < 2; ++a)
#pragma unroll
            for (int b = 0; b < 2; ++b)
#pragma unroll
                for (int m = 0; m < 4; ++m)
#pragma unroll
                    for (int n = 0; n < 2; ++n) acc[a][b][m][n] = (f32x4){0.f, 0.f, 0.f, 0.f};
        const char* A = S.a_tile(cur); const char* B = S.b_tile(cur);
#pragma unroll 1
        for (int kt = 0; kt < nt; ++kt) {
#pragma unroll
            for (int ai = 0; ai < 2; ++ai) {
                bf16x8 At[4][2]; const char* Ab = A + (size_t)ai * 128 * lda * 2 + kt * 128;
#pragma unroll
                for (int m = 0; m < 4; ++m)
#pragma unroll
                    for (int k = 0; k < 2; ++k) At[m][k] = *(const bf16x8*)(Ab + k * 64 + offA[m]);
#pragma unroll
                for (int bj = 0; bj < 2; ++bj) {
                    bf16x8 Bf[2][2]; const char* Bb = B + (size_t)bj * 128 * ldb * 2 + kt * 128;
#pragma unroll
                    for (int n = 0; n < 2; ++n)
#pragma unroll
                        for (int k = 0; k < 2; ++k) Bf[n][k] = *(const bf16x8*)(Bb + k * 64 + offB[n]);
#pragma unroll
                    for (int m = 0; m < 4; ++m)
#pragma unroll
                        for (int n = 0; n < 2; ++n)
#pragma unroll
                            for (int k = 0; k < 2; ++k) acc[ai][bj][m][n] = __builtin_amdgcn_mfma_f32_16x16x32_bf16(Bf[n][k], At[m][k], acc[ai][bj][m][n], 0, 0, 0);
                }
            }
            asm volatile("" ::: "memory");
        }
        { int fr2 = fr, fq2 = fq; asm volatile("" : "+v"(fr2), "+v"(fq2)); E(acc, cur, wr, wc, fr2, fq2, xl); }
    }
    __syncthreads();
}
#endif

struct SchedPlain {
    const bf16_t* A; const bf16_t* B; int lda, ldb, K, nM, nN, G, c;
    __device__ __forceinline__ bool next(int i, Unit& u) const { return static_order((long)i * G + c, nM, nN, u); }
    __device__ __forceinline__ const char* a_tile(const Unit& u) const { return (const char*)(A + (size_t)u.pm * BM * lda); }
    __device__ __forceinline__ const char* b_tile(const Unit& u) const { return (const char*)(B + (size_t)u.pn * BM * ldb); }
};
struct SchedSsm {
    const bf16_t* A; const bf16_t* B; int lda, ldb, K, G, c;
    __device__ __forceinline__ bool next(int i, Unit& u) const { const int L = i * G + c; if (L >= NG * 8) return false; u.g = L >> 3; u.pm = L & 7; u.pn = 0; return true; }
    __device__ __forceinline__ const char* a_tile(const Unit& u) const { return (const char*)(A + ((size_t)u.g * CROWS + (size_t)u.pm * BM) * lda); }
    __device__ __forceinline__ const char* b_tile(const Unit& u) const { return (const char*)(B + (size_t)u.g * 256 * ldb); }
};
struct SchedAttn {
    const bf16_t* A; const bf16_t* B; int lda, ldb, K, G, c, pv;
    __device__ __forceinline__ bool next(int i, Unit& u) const { const int L = i * G + c; if (L >= NB * NH * 16) return false; const int bh = L >> 4, rt = L & 15; u.g = bh >> 2; u.pn = bh & 3; u.pm = u.g * 16 + rt; return true; }
    __device__ __forceinline__ const char* a_tile(const Unit& u) const { return (const char*)(A + (size_t)u.pm * BM * lda + u.pn * HD); }
    __device__ __forceinline__ const char* b_tile(const Unit& u) const { return (const char*)(pv ? (B + (size_t)u.pn * HD * ldb + u.g * NMEM) : (B + (size_t)u.g * NMEM * ldb + u.pn * HD)); }
};
struct SchedKv {
    const bf16_t* wkv; const bf16_t* memb; int lda, ldb, K, G, c;
    __device__ __forceinline__ bool next(int i, Unit& u) const { const int L = i * G + c; if (L >= DEPTH * 64) return false; u.g = L >> 5; const int r = L & 31; if (u.g & 1) { u.pm = r >> 3; u.pn = r & 7; } else { u.pm = r >> 2; u.pn = r & 3; } return true; }
    __device__ __forceinline__ const char* a_tile(const Unit& u) const { return (const char*)((u.g & 1) ? (wkv + (size_t)u.g * D * D + (size_t)u.pm * BM * D) : (memb + (size_t)u.pm * BM * D)); }
    __device__ __forceinline__ const char* b_tile(const Unit& u) const { return (const char*)((u.g & 1) ? (memb + (size_t)u.pn * BM * D) : (wkv + (size_t)u.g * D * D + (size_t)u.pn * BM * D)); }
};
struct SchedMoe {
    const bf16_t* A; const bf16_t* B; const unsigned* meta; int lda, ldb, K, nM, nN, G, c;
    __device__ __forceinline__ bool next(int i, Unit& u) const { if (!static_order((long)i * G + c, nM, nN, u)) return false; u.g = (int)meta[16 + u.pm]; return true; }
    __device__ __forceinline__ const char* a_tile(const Unit& u) const { return (const char*)(A + (size_t)u.pm * BM * lda); }
    __device__ __forceinline__ const char* b_tile(const Unit& u) const { return (const char*)(B + ((size_t)u.g * nN * BM + (size_t)u.pn * BM) * ldb); }
};

#define EPI_ARGS f32x4 (&acc)[2][2][4][2], const Unit& u, int wr, int wc, int fr, int fq, LAS unsigned char* xl
#define FOR_ROWS _Pragma("unroll") for (int ai = 0; ai < 2; ++ai) _Pragma("unroll") for (int m = 0; m < 4; ++m)
#define FOR_BJ _Pragma("unroll") for (int bj = 0; bj < 2; ++bj)
__device__ __forceinline__ u32x4 pack8(const f32x4 a, const f32x4 b) { u32x4 w; w.x = cvt_pk_bf16(a[0], a[1]); w.y = cvt_pk_bf16(a[2], a[3]); w.z = cvt_pk_bf16(b[0], b[1]); w.w = cvt_pk_bf16(b[2], b[3]); return w; }

struct EpiProj { static constexpr bool PERM = true; bf16_t* uc; bf16_t* upool; bf16_t* gates;
    __device__ __forceinline__ void operator()(EPI_ARGS) const {
        FOR_ROWS { const int row = u.pm * 256 + ai * 128 + wr * 64 + m * 16 + fr;
            FOR_BJ { const int col = u.pn * 256 + bj * 128 + wc * 32 + 8 * fq; f32x4 v0 = acc[ai][bj][m][0], v1 = acc[ai][bj][m][1];
                if (u.pn < 2) { *(u32x4*)(uc + ((size_t)(col >> 4) * CROWS + (row >> 4)) * UCLD + (row & 15) * 16 + (col & 15)) = pack8(v0, v1); }
                else if (u.pn < 4) { *(u32x4*)(upool + (size_t)row * 512 + (col - 512)) = pack8(v0, v1); }
                else {
#pragma unroll
                    for (int j = 0; j < 4; ++j) { v0[j] = fast_sigmoid(v0[j]); v1[j] = fast_sigmoid(v1[j]); }
                    *(u32x4*)(gates + (size_t)row * 2048 + (col - 1024)) = pack8(v0, v1); } }
            asm volatile("" ::: "memory"); }
    }
};
struct EpiBf16 { static constexpr bool PERM = true; bf16_t* O; int ldc; float scale; size_t gstride;
    __device__ __forceinline__ void operator()(EPI_ARGS) const {
        bf16_t* base = O + (size_t)u.g * gstride;
        FOR_ROWS { const int row = u.pm * 256 + ai * 128 + wr * 64 + m * 16 + fr;
            FOR_BJ { const int col = u.pn * 256 + bj * 128 + wc * 32 + 8 * fq;
                *(u32x4*)(base + (size_t)row * ldc + col) = pack8(acc[ai][bj][m][0] * scale, acc[ai][bj][m][1] * scale); } }
    }
};
struct EpiKv { static constexpr bool PERM = true; bf16_t* mats;
    __device__ __forceinline__ void operator()(EPI_ARGS) const {
        const int isv = u.g & 1; bf16_t* base = mats + (size_t)(u.g >> 1) * (2 * MROWS * D) + (isv ? (size_t)MROWS * D : 0); const int ldc = isv ? MROWS : D;
        FOR_ROWS { const int row = u.pm * 256 + ai * 128 + wr * 64 + m * 16 + fr;
            FOR_BJ { const int col = u.pn * 256 + bj * 128 + wc * 32 + 8 * fq;
                *(u32x4*)(base + (size_t)row * ldc + col) = pack8(acc[ai][bj][m][0], acc[ai][bj][m][1]); } }
    }
};
struct EpiSsmE { static constexpr bool PERM = false; float* E;
    __device__ __forceinline__ void operator()(EPI_ARGS) const {
        FOR_ROWS { const int row = u.pm * 256 + ai * 128 + wr * 64 + m * 16 + fr;
#pragma unroll
            for (int n = 0; n < 2; ++n) { const int col = wc * 32 + 16 * n + 4 * fq;
                *(f32x4*)(E + ((size_t)u.g * CROWS + row) * 128 + col) = acc[ai][0][m][n]; } }
    }
};
struct EpiSsmY { static constexpr bool PERM = true; const bf16_t* uc; const float* dvec; bf16_t* ysg;
    __device__ __forceinline__ void operator()(EPI_ARGS) const {
        const int c0 = (8 * fq) & 15;
        const f32x4 d0 = *(const f32x4*)(dvec + u.g * 16 + c0), d1 = *(const f32x4*)(dvec + u.g * 16 + c0 + 4);
        FOR_ROWS { const int R = u.pm * 256 + ai * 128 + wr * 64 + m * 16 + fr;
            FOR_BJ { const int n0 = bj * 128 + wc * 32 + 8 * fq, tt = n0 >> 4;
                const u32x4 uu = *(const u32x4*)(uc + ((size_t)u.g * CROWS + R) * UCLD + n0);
                f32x4 v0 = acc[ai][bj][m][0], v1 = acc[ai][bj][m][1];
                v0[0] += d0[0] * bf_lo(uu.x); v0[1] += d0[1] * bf_hi(uu.x); v0[2] += d0[2] * bf_lo(uu.y); v0[3] += d0[3] * bf_hi(uu.y);
                v1[0] += d1[0] * bf_lo(uu.z); v1[1] += d1[1] * bf_hi(uu.z); v1[2] += d1[2] * bf_lo(uu.w); v1[3] += d1[3] * bf_hi(uu.w);
#pragma unroll
                for (int j = 0; j < 4; ++j) { v0[j] = gelu_tanh(v0[j]); v1[j] = gelu_tanh(v1[j]); }
                *(u32x4*)(ysg + ((size_t)R * 16 + tt) * 512 + u.g * 16 + c0) = pack8(v0, v1); }
            asm volatile("" ::: "memory"); }
    }
};
struct EpiGlu { static constexpr bool PERM = true; const bf16_t* ysg; const float* bias; bf16_t* out;
    __device__ __forceinline__ void operator()(EPI_ARGS) const {
        FOR_ROWS { const int row = u.pm * 256 + ai * 128 + wr * 64 + m * 16 + fr;
            FOR_BJ { const int col = u.pn * 256 + bj * 128 + wc * 32 + 8 * fq;
                const u32x4 yy = *(const u32x4*)(ysg + (size_t)row * 512 + col);
                const f32x4 b0 = *(const f32x4*)(bias + col), b1 = *(const f32x4*)(bias + col + 4);
                f32x4 v0 = acc[ai][bj][m][0] + b0, v1 = acc[ai][bj][m][1] + b1;
                v0[0] = bf_lo(yy.x) * fast_sigmoid(v0[0]); v0[1] = bf_hi(yy.x) * fast_sigmoid(v0[1]); v0[2] = bf_lo(yy.y) * fast_sigmoid(v0[2]); v0[3] = bf_hi(yy.y) * fast_sigmoid(v0[3]);
                v1[0] = bf_lo(yy.z) * fast_sigmoid(v1[0]); v1[1] = bf_hi(yy.z) * fast_sigmoid(v1[1]); v1[2] = bf_lo(yy.w) * fast_sigmoid(v1[2]); v1[3] = bf_hi(yy.w) * fast_sigmoid(v1[3]);
                *(u32x4*)(out + (size_t)row * 512 + col) = pack8(v0, v1); }
            asm volatile("" ::: "memory"); }
    }
};
template <bool ADD> struct EpiUp { static constexpr bool PERM = true; const bf16_t* gates; bf16_t* inner;
    __device__ __forceinline__ void operator()(EPI_ARGS) const {
        FOR_ROWS { const int row = u.pm * 256 + ai * 128 + wr * 64 + m * 16 + fr;
            FOR_BJ { const int col = u.pn * 256 + bj * 128 + wc * 32 + 8 * fq;
                const u32x4 gg = *(const u32x4*)(gates + (size_t)row * 2048 + col);
                f32x4 v0 = acc[ai][bj][m][0], v1 = acc[ai][bj][m][1];
                v0[0] *= bf_lo(gg.x); v0[1] *= bf_hi(gg.x); v0[2] *= bf_lo(gg.y); v0[3] *= bf_hi(gg.y);
                v1[0] *= bf_lo(gg.z); v1[1] *= bf_hi(gg.z); v1[2] *= bf_lo(gg.w); v1[3] *= bf_hi(gg.w);
                if (ADD) { const u32x4 pp = *(const u32x4*)(inner + (size_t)row * D + col);
                    v0[0] += bf_lo(pp.x); v0[1] += bf_hi(pp.x); v0[2] += bf_lo(pp.y); v0[3] += bf_hi(pp.y);
                    v1[0] += bf_lo(pp.z); v1[1] += bf_hi(pp.z); v1[2] += bf_lo(pp.w); v1[3] += bf_hi(pp.w); }
                *(u32x4*)(inner + (size_t)row * D + col) = pack8(v0, v1); }
            asm volatile("" ::: "memory"); }
    }
};
struct EpiRes { static constexpr bool PERM = false; float* x;
    __device__ __forceinline__ void operator()(EPI_ARGS) const {
        FOR_ROWS { float* rowp = x + (size_t)(u.pm * 256 + ai * 128 + wr * 64 + m * 16 + fr) * D + u.pn * 256 + wc * 32 + 4 * fq;
            FOR_BJ {
#pragma unroll
                for (int n = 0; n < 2; ++n) { float* p = rowp + bj * 128 + n * 16; const f32x4 xv = *(const f32x4*)p; *(f32x4*)p = xv * ALPHA + acc[ai][bj][m][n]; } }
            asm volatile("" ::: "memory"); }
    }
};
struct EpiSoftmax { static constexpr bool PERM = true; bf16_t* P;
    __device__ __forceinline__ void operator()(EPI_ARGS) const {
        LAS f32x2* tab = (LAS f32x2*)xl;
        float mloc[2][4];
        FOR_ROWS { const int r = ai * 128 + wr * 64 + m * 16 + fr;
            float mx = -3.0e38f;
            FOR_BJ {
#pragma unroll
                for (int n = 0; n < 2; ++n)
#pragma unroll
                    for (int j = 0; j < 4; ++j) mx = fmaxf(mx, acc[ai][bj][m][n][j]); }
            mx = fmaxf(mx, __shfl_xor(mx, 16)); mx = fmaxf(mx, __shfl_xor(mx, 32));
            float s = 0.f;
            FOR_BJ {
#pragma unroll
                for (int n = 0; n < 2; ++n)
#pragma unroll
                    for (int j = 0; j < 4; ++j) { const float e = __builtin_amdgcn_exp2f((acc[ai][bj][m][n][j] - mx) * 1.4426950408889634f); acc[ai][bj][m][n][j] = e; s += e; } }
            s += __shfl_xor(s, 16); s += __shfl_xor(s, 32);
            mloc[ai][m] = mx;
            if (fq == 0) tab[r * 4 + wc] = (f32x2){mx, s};
        }
        LDS_WAIT(); __builtin_amdgcn_s_barrier(); asm volatile("" ::: "memory");
        FOR_ROWS { const int r = ai * 128 + wr * 64 + m * 16 + fr;
            const f32x2 t0 = tab[r * 4 + 0], t1 = tab[r * 4 + 1], t2 = tab[r * 4 + 2], t3 = tab[r * 4 + 3];
            const float M = fmaxf(fmaxf(t0.x, t1.x), fmaxf(t2.x, t3.x));
            const float tot = t0.y * __builtin_amdgcn_exp2f((t0.x - M) * 1.4426950408889634f) + t1.y * __builtin_amdgcn_exp2f((t1.x - M) * 1.4426950408889634f)
                            + t2.y * __builtin_amdgcn_exp2f((t2.x - M) * 1.4426950408889634f) + t3.y * __builtin_amdgcn_exp2f((t3.x - M) * 1.4426950408889634f);
            const float f = __builtin_amdgcn_exp2f((mloc[ai][m] - M) * 1.4426950408889634f) / tot;
            const int row = u.pm * 256 + r;
            FOR_BJ { const int col = u.pn * 256 + bj * 128 + wc * 32 + 8 * fq;
                *(u32x4*)(P + (size_t)row * D + col) = pack8(acc[ai][bj][m][0] * f, acc[ai][bj][m][1] * f); } }
        LDS_WAIT(); __builtin_amdgcn_s_barrier(); asm volatile("" ::: "memory");
    }
};
struct EpiSwiglu { static constexpr bool PERM = true; bf16_t* H; int ldh;
    __device__ __forceinline__ void operator()(EPI_ARGS) const {
        FOR_ROWS { const int row = u.pm * 256 + ai * 128 + wr * 64 + m * 16 + fr;
            FOR_BJ { const int hid = u.pn * 128 + bj * 64 + wc * 16 + 4 * fq; const f32x4 a = acc[ai][bj][m][0], b = acc[ai][bj][m][1]; f32x4 h;
#pragma unroll
                for (int j = 0; j < 4; ++j) h[j] = a[j] * fast_sigmoid(a[j]) * b[j];
                u32x2 w; w.x = cvt_pk_bf16(h[0], h[1]); w.y = cvt_pk_bf16(h[2], h[3]);
                *(u32x2*)(H + (size_t)row * ldh + hid) = w; } }
    }
};
}

struct Args { const float* in[35]; float* out; unsigned char* ws; int ph_lo, ph_hi; };
struct Frame {
    LAS unsigned char* lds; volatile LAS unsigned* MISC; unsigned* ctl;
    int tid, lane, wave, G, gw, NGW;
    unsigned char* ws; float* x; bf16_t* xb;
};
constexpr int NWAVES = 8;

__device__ __forceinline__ void transpose_item(const float* W, int K, int N, bf16_t* WT, int row_off, int mode, LAS float* scr, int item, int lane) {
    const int nblk = N / 32, kb = item / nblk, nb = item % nblk, k0 = 64 * kb, n0 = 32 * nb;
#pragma unroll 8
    for (int i = 0; i < 32; ++i) { const int kk = 2 * i + (lane >> 5); scr[kk * 33 + (lane & 31)] = W[(size_t)(k0 + kk) * N + n0 + (lane & 31)]; }
    LDS_WAIT(); asm volatile("" ::: "memory");
    const int c = lane & 7;
#pragma unroll
    for (int j = 0; j < 4; ++j) { const int n = (lane >> 3) + 8 * j; const LAS float* s = scr + (8 * c) * 33 + n;
        u32x4 o; o.x = cvt_pk_bf16(s[0 * 33], s[1 * 33]); o.y = cvt_pk_bf16(s[2 * 33], s[3 * 33]); o.z = cvt_pk_bf16(s[4 * 33], s[5 * 33]); o.w = cvt_pk_bf16(s[6 * 33], s[7 * 33]);
        const int nn = n0 + n; const int row = mode == 0 ? (row_off + nn) : (8 * (nn >> 2) + (nn & 3) + (mode == 2 ? 4 : 0));
        *(u32x4*)(WT + (size_t)row * K + k0 + 8 * c) = o; }
    LDS_WAIT(); asm volatile("" ::: "memory");
}
__device__ __forceinline__ void transpose_all(Frame& F, const float* W, int K, int N, bf16_t* WT, int row_off, int mode) {
    LAS float* scr = (LAS float*)(F.lds + F.wave * 16384);
    const int nit = (K / 64) * (N / 32);
    for (int it = F.gw; it < nit; it += F.NGW) transpose_item(W, K, N, WT, row_off, mode, scr, it, F.lane);
}

__device__ __forceinline__ void ln_regs(f32x4 (&v)[4], const f32x4 (&gv)[4], const f32x4 (&bv)[4]) {
    float s = 0.f;
#pragma unroll
    for (int j = 0; j < 4; ++j) s += (v[j].x + v[j].y) + (v[j].z + v[j].w);
    const float mean = wave_sum(s) * (1.f / D); float s2 = 0.f;
#pragma unroll
    for (int j = 0; j < 4; ++j) { v[j] = v[j] - mean; s2 += (v[j].x * v[j].x + v[j].y * v[j].y) + (v[j].z * v[j].z + v[j].w * v[j].w); }
    const float rstd = 1.f / sqrtf(wave_sum(s2) * (1.f / D) + LN_EPS);
#pragma unroll
    for (int j = 0; j < 4; ++j) v[j] = v[j] * rstd * gv[j] + bv[j];
}
__device__ __forceinline__ void store_row(Frame& F, int m, const f32x4 (&v)[4]) {
    f32x4* xr = (f32x4*)(F.x + (size_t)m * D) + F.lane; u32x2* o8 = (u32x2*)(F.xb + (size_t)m * D) + F.lane;
#pragma unroll
    for (int j = 0; j < 4; ++j) { xr[64 * j] = v[j]; u32x2 w; w.x = cvt_pk_bf16(v[j].x, v[j].y); w.y = cvt_pk_bf16(v[j].z, v[j].w); o8[64 * j] = w; }
}
template <int MODE>
__device__ __forceinline__ void ln_phase(Frame& F, const float* g, const float* b, const float* router, uint4* tokinfo, const uint2* tokpos, const bf16_t* Y) {
    f32x4 gv[4], bv[4];
#pragma unroll
    for (int j = 0; j < 4; ++j) { gv[j] = ((const f32x4*)g)[F.lane + 64 * j]; bv[j] = ((const f32x4*)b)[F.lane + 64 * j]; }
    LAS float* rt = (LAS float*)F.lds;
    LAS int* hist = (LAS int*)(F.lds + 32768);
    if (MODE == 1) {
        for (int i = F.tid; i < D * NE / 4; i += NWAVES * 64) ((LAS f32x4*)rt)[i] = ((const f32x4*)router)[i];
        if (F.tid < NE) hist[F.tid] = 0;
        __syncthreads();
    }
    for (int m = F.gw; m < T; m += F.NGW) {
        const f32x4* xr = (const f32x4*)(F.x + (size_t)m * D) + F.lane;
        f32x4 v[4];
#pragma unroll
        for (int j = 0; j < 4; ++j) v[j] = xr[64 * j];
        if (MODE == 2) {
            const uint4 ti = tokinfo[m]; const uint2 tp = tokpos[m]; const float w0 = __uint_as_float(ti.z), w1 = __uint_as_float(ti.w);
            const u32x2* y0 = (const u32x2*)(Y + (size_t)tp.x * D) + F.lane; const u32x2* y1 = (const u32x2*)(Y + (size_t)tp.y * D) + F.lane;
#pragma unroll
            for (int j = 0; j < 4; ++j) { const u32x2 a = y0[64 * j], c = y1[64 * j];
                v[j].x = ALPHA * v[j].x + w0 * bf_lo(a.x) + w1 * bf_lo(c.x); v[j].y = ALPHA * v[j].y + w0 * bf_hi(a.x) + w1 * bf_hi(c.x);
                v[j].z = ALPHA * v[j].z + w0 * bf_lo(a.y) + w1 * bf_lo(c.y); v[j].w = ALPHA * v[j].w + w0 * bf_hi(a.y) + w1 * bf_hi(c.y); }
        }
        ln_regs(v, gv, bv);
        store_row(F, m, v);
        if (MODE == 1) {
            float lg[NE];
#pragma unroll
            for (int e = 0; e < NE; ++e) lg[e] = 0.f;
#pragma unroll
            for (int j = 0; j < 4; ++j)
#pragma unroll
                for (int q = 0; q < 4; ++q) { const int k = 4 * F.lane + 256 * j + q; const f32x4 r0 = *(const LAS f32x4*)(rt + k * 8), r1 = *(const LAS f32x4*)(rt + k * 8 + 4); const float xv = v[j][q];
                    lg[0] += xv * r0.x; lg[1] += xv * r0.y; lg[2] += xv * r0.z; lg[3] += xv * r0.w; lg[4] += xv * r1.x; lg[5] += xv * r1.y; lg[6] += xv * r1.z; lg[7] += xv * r1.w; }
#pragma unroll
            for (int e = 0; e < NE; ++e) lg[e] = wave_sum(lg[e]);
            int e0 = 0; float v0 = lg[0];
#pragma unroll
            for (int e = 1; e < NE; ++e) if (lg[e] > v0) { v0 = lg[e]; e0 = e; }
            int e1 = -1; float v1 = -3.0e38f;
#pragma unroll
            for (int e = 0; e < NE; ++e) if (e != e0 && lg[e] > v1) { v1 = lg[e]; e1 = e; }
            const float ex = __expf(v1 - v0), w0 = 1.f / (1.f + ex), w1 = ex / (1.f + ex);
            if (F.lane == 0) { const int r0 = __hip_atomic_fetch_add(hist + e0, 1, __ATOMIC_RELAXED, __HIP_MEMORY_SCOPE_WORKGROUP), r1 = __hip_atomic_fetch_add(hist + e1, 1, __ATOMIC_RELAXED, __HIP_MEMORY_SCOPE_WORKGROUP);
                tokinfo[m] = make_uint4((unsigned)e0 | ((unsigned)r0 << 8), (unsigned)e1 | ((unsigned)r1 << 8), __float_as_uint(w0), __float_as_uint(w1)); }
        }
    }
    if (MODE == 1) { __syncthreads(); if (F.tid < NE) F.ctl[CW_WGHIST + blockIdx.x * 8 + F.tid] = (unsigned)hist[F.tid]; }
}

__device__ __forceinline__ void moe_gather_phase(Frame& F, const uint4* tokinfo, uint2* tokpos, bf16_t* XS) {
    LAS int* tot = (LAS int*)F.lds; LAS int* pre = tot + 8; LAS int* base = tot + 16;
    { const int e = F.wave; int st = 0, sp = 0;
      for (int w = F.lane; w < F.G; w += 64) { const int v = (int)F.ctl[CW_WGHIST + w * 8 + e]; st += v; if (w < (int)blockIdx.x) sp += v; }
      st = wave_sum_i(st); sp = wave_sum_i(sp); if (F.lane == 0) { tot[e] = st; pre[e] = sp; } }
    __syncthreads();
    if (F.tid == 0) { int off = 0;
        for (int e = 0; e < NE; ++e) { base[e] = off + pre[e]; const int nt = (tot[e] + 255) >> 8;
            if (blockIdx.x == 0) for (int t = 0; t < nt; ++t) F.ctl[CW_META + 16 + (off >> 8) + t] = (unsigned)e;
            off += nt << 8; }
        if (blockIdx.x == 0) F.ctl[CW_META] = (unsigned)(off >> 8); }
    __syncthreads();
    for (int m = F.gw; m < T; m += F.NGW) {
        const uint4 ti = tokinfo[m];
        const unsigned p0 = (unsigned)base[ti.x & 255u] + (ti.x >> 8), p1 = (unsigned)base[ti.y & 255u] + (ti.y >> 8);
        if (F.lane == 0) tokpos[m] = make_uint2(p0, p1);
        const u32x4* src = (const u32x4*)(F.xb + (size_t)m * D) + F.lane; u32x4* d0 = (u32x4*)(XS + (size_t)p0 * D) + F.lane; u32x4* d1 = (u32x4*)(XS + (size_t)p1 * D) + F.lane;
        const u32x4 a = src[0], c = src[64]; d0[0] = a; d0[64] = c; d1[0] = a; d1[64] = c;
    }
}

__device__ __forceinline__ void init_phase(Frame& F, const Args& a) {
    const f32x4* xs = (const f32x4*)a.in[0]; f32x4* xo = (f32x4*)F.x; u32x2* xbo = (u32x2*)F.xb;
    for (size_t i = (size_t)blockIdx.x * 512 + F.tid; i < (size_t)T * D / 4; i += (size_t)F.G * 512) { const f32x4 v = xs[i]; xo[i] = v; u32x2 w; w.x = cvt_pk_bf16(v.x, v.y); w.y = cvt_pk_bf16(v.z, v.w); xbo[i] = w; }
    const f32x4* ms = (const f32x4*)a.in[1]; u32x2* mo = (u32x2*)(F.ws + WS_KV + KV_MEMB);
    for (size_t i = (size_t)blockIdx.x * 512 + F.tid; i < (size_t)MROWS * D / 4; i += (size_t)F.G * 512) { const f32x4 v = ms[i]; u32x2 w; w.x = cvt_pk_bf16(v.x, v.y); w.y = cvt_pk_bf16(v.z, v.w); mo[i] = w; }
    bf16_t* wkv = (bf16_t*)(F.ws + WS_KV + KV_WKV);
    for (int l = 0; l < DEPTH; ++l) {
        transpose_all(F, a.in[23] + (size_t)l * D * D, D, D, wkv + (size_t)(2 * l) * D * D, 0, 0);
        transpose_all(F, a.in[24] + (size_t)l * D * D, D, D, wkv + (size_t)(2 * l + 1) * D * D, 0, 0);
    }
}

__device__ __forceinline__ void ssm_mats(Frame& F, const Args& a, int l, bf16_t* BT1, bf16_t* BT2) {
    LAS float* pwr = (LAS float*)F.lds;
    LAS float* pwi = pwr + 17 * 64;
    LAS float* bbr = pwi + 17 * 64;
    LAS float* bbi = bbr + 1024;
    LAS float* cr = bbi + 1024;
    LAS float* ci = cr + 1024;
    LAS float* km = ci + 1024;
    for (int g = blockIdx.x; g < NG; g += F.G) {
        __syncthreads();
        const float* are = a.in[5] + (size_t)(l * NG + g) * NP; const float* aim = a.in[6] + (size_t)(l * NG + g) * NP; const float dt = __expf(a.in[7][l * NG + g]);
        if (F.tid < NP) { const int p = F.tid; const float ar = are[p], ai = aim[p];
            const float mag = expf(ar * dt), ang = ai * dt, lr = mag * cosf(ang), li = mag * sinf(ang);
            float pr = 1.f, pi = 0.f;
            for (int k = 0; k <= 16; ++k) { pwr[k * 64 + p] = pr; pwi[k * 64 + p] = pi; const float nr = pr * lr - pi * li, ni = pr * li + pi * lr; pr = nr; pi = ni; }
            const float den = ar * ar + ai * ai, nre = lr - 1.f, fre = (nre * ar + li * ai) / den, fim = (li * ar - nre * ai) / den;
            const float* br = a.in[8] + ((size_t)(l * NG + g) * NP + p) * GC; const float* bi = a.in[9] + ((size_t)(l * NG + g) * NP + p) * GC;
            for (int c = 0; c < GC; ++c) { bbr[p * 16 + c] = fre * br[c] - fim * bi[c]; bbi[p * 16 + c] = fre * bi[c] + fim * br[c]; } }
        for (int i = F.tid; i < GC * NP; i += 512) { cr[i] = a.in[10][(size_t)(l * NG + g) * GC * NP + i]; ci[i] = a.in[11][(size_t)(l * NG + g) * GC * NP + i]; }
        __syncthreads();
        for (int o = F.tid; o < 4096; o += 512) { const int lag = o >> 8, c = (o >> 4) & 15, cp = o & 15; float s = 0.f;
            for (int p = 0; p < NP; ++p) { const float gr = cr[c * 64 + p] * pwr[lag * 64 + p] - ci[c * 64 + p] * pwi[lag * 64 + p], gi = cr[c * 64 + p] * pwi[lag * 64 + p] + ci[c * 64 + p] * pwr[lag * 64 + p];
                s += gr * bbr[p * 16 + cp] - gi * bbi[p * 16 + cp]; }
            km[o] = s; }
        __syncthreads();
        bf16_t* b2 = BT2 + (size_t)g * 256 * UCLD;
        for (int o = F.tid; o < 256 * UCLD / 2; o += 512) { const int n = o / (UCLD / 2), k2 = (o % (UCLD / 2)) * 2, t = n >> 4, c = n & 15; float v[2];
#pragma unroll
            for (int q = 0; q < 2; ++q) { const int k = k2 + q;
                if (k < 256) { const int s = k >> 4, cp = k & 15; v[q] = s <= t ? km[((t - s) << 8) + (c << 4) + cp] : 0.f; }
                else { const int p = (k - 256) & 63; const float gr = cr[c * 64 + p] * pwr[(t + 1) * 64 + p] - ci[c * 64 + p] * pwi[(t + 1) * 64 + p], gi = cr[c * 64 + p] * pwi[(t + 1) * 64 + p] + ci[c * 64 + p] * pwr[(t + 1) * 64 + p];
                    v[q] = k < 320 ? gr : -gi; } }
            *(unsigned*)(b2 + (size_t)n * UCLD + k2) = cvt_pk_bf16(v[0], v[1]); }
        bf16_t* b1 = BT1 + (size_t)g * 256 * 256;
        for (int o = F.tid; o < 256 * 128; o += 512) { const int n = o >> 7, k2 = (o & 127) * 2; float v[2];
#pragma unroll
            for (int q = 0; q < 2; ++q) { const int k = k2 + q, s = k >> 4, cp = k & 15;
                if (n < 128) { const int p = n & 63; const float lr = pwr[(15 - s) * 64 + p], li = pwi[(15 - s) * 64 + p];
                    v[q] = n < 64 ? (lr * bbr[p * 16 + cp] - li * bbi[p * 16 + cp]) : (lr * bbi[p * 16 + cp] + li * bbr[p * 16 + cp]); }
                else v[q] = 0.f; }
            *(unsigned*)(b1 + (size_t)n * 256 + k2) = cvt_pk_bf16(v[0], v[1]); }
    }
    __syncthreads();
}

__device__ __forceinline__ void prep_phase(Frame& F, const Args& a, int l) {
    unsigned char* wl = F.ws + WS_WL; unsigned char* fw = F.ws + WS_FFW;
    ssm_mats(F, a, l, (bf16_t*)(wl + WL_BT1), (bf16_t*)(wl + WL_BT2));
    transpose_all(F, a.in[4] + (size_t)l * D * INC, D, INC, (bf16_t*)(wl + WL_WIN), 0, 0);
    transpose_all(F, a.in[13] + (size_t)l * SSMW * SSMW, SSMW, SSMW, (bf16_t*)(wl + WL_WGLU), 0, 0);
    transpose_all(F, a.in[15] + (size_t)l * SSMW * D, SSMW, D, (bf16_t*)(wl + WL_WSUP), 0, 0);
    transpose_all(F, a.in[18] + (size_t)l * SSMW * D, SSMW, D, (bf16_t*)(wl + WL_WPUP), 0, 0);
    transpose_all(F, a.in[19] + (size_t)l * D * D, D, D, (bf16_t*)(wl + WL_WOUT), 0, 0);
    transpose_all(F, a.in[22] + (size_t)l * D * D, D, D, (bf16_t*)(wl + WL_WQ), 0, 0);
    transpose_all(F, a.in[25] + (size_t)l * D * D, D, D, (bf16_t*)(wl + WL_WO), 0, 0);
    { bf16_t* wp = (bf16_t*)(wl + WL_WPBD); const float* pw = a.in[16] + (size_t)l * 4 * 128 * 128; const float* ps = a.in[17] + (size_t)l * 512;
      for (size_t i = (size_t)blockIdx.x * 512 + F.tid; i < 512 * 512 / 2; i += (size_t)F.G * 512) { const int n = (int)(i >> 8), k = (int)(i & 255) * 2, gn = n >> 7, d = n & 127; float v0 = 0.f, v1 = 0.f;
          if ((k >> 7) == gn) { const float sc = ps[n]; v0 = pw[((size_t)gn * 128 + (k & 127)) * 128 + d] * sc; v1 = pw[((size_t)gn * 128 + ((k + 1) & 127)) * 128 + d] * sc; }
          *(unsigned*)(wp + (size_t)n * 512 + k) = cvt_pk_bf16(v0, v1); } }
    if ((l & 1) == 0) {
        const int li = l >> 1;
        transpose_all(F, a.in[28] + (size_t)li * D * FFD, D, FFD, (bf16_t*)(fw + FW_W13), 0, 1);
        transpose_all(F, a.in[29] + (size_t)li * D * FFD, D, FFD, (bf16_t*)(fw + FW_W13), 0, 2);
        transpose_all(F, a.in[30] + (size_t)li * FFD * D, FFD, D, (bf16_t*)(fw + FW_W2), 0, 0);
    } else {
        const int li = l >> 1;
        for (int e = 0; e < NE; ++e) {
            transpose_all(F, a.in[32] + ((size_t)li * NE + e) * D * FFE, D, FFE, (bf16_t*)(fw + FW_W13) + (size_t)e * 2 * FFE * D, 0, 1);
            transpose_all(F, a.in[33] + ((size_t)li * NE + e) * D * FFE, D, FFE, (bf16_t*)(fw + FW_W13) + (size_t)e * 2 * FFE * D, 0, 2);
            transpose_all(F, a.in[34] + ((size_t)li * NE + e) * FFE * D, FFE, D, (bf16_t*)(fw + FW_W2) + (size_t)e * D * FFE, 0, 0);
        }
    }
}

__device__ __forceinline__ void pool_phase(Frame& F, const bf16_t* up, bf16_t* pooled) {
    for (size_t it = (size_t)blockIdx.x * 512 + F.tid; it < (size_t)T * 64; it += (size_t)F.G * 512) {
        const int tok = (int)(it >> 6), cc = (int)(it & 63), win = 2 << (cc >> 4), pos = tok & (SEQ - 1), n = (pos + 1) < win ? (pos + 1) : win;
        const bf16_t* p = up + (size_t)tok * 512 + cc * 8;
        const u32x4 cur = *(const u32x4*)p; float s[8];
        s[0] = bf_lo(cur.x); s[1] = bf_hi(cur.x); s[2] = bf_lo(cur.y); s[3] = bf_hi(cur.y); s[4] = bf_lo(cur.z); s[5] = bf_hi(cur.z); s[6] = bf_lo(cur.w); s[7] = bf_hi(cur.w);
        float c0[8];
#pragma unroll
        for (int j = 0; j < 8; ++j) c0[j] = s[j];
        for (int q = 1; q < n; ++q) { const u32x4 w = *(const u32x4*)(p - (size_t)q * 512);
            s[0] += bf_lo(w.x); s[1] += bf_hi(w.x); s[2] += bf_lo(w.y); s[3] += bf_hi(w.y); s[4] += bf_lo(w.z); s[5] += bf_hi(w.z); s[6] += bf_lo(w.w); s[7] += bf_hi(w.w); }
        const float inv = 1.f / (float)n; u32x4 o;
        o.x = cvt_pk_bf16(s[0] * inv - c0[0], s[1] * inv - c0[1]); o.y = cvt_pk_bf16(s[2] * inv - c0[2], s[3] * inv - c0[3]);
        o.z = cvt_pk_bf16(s[4] * inv - c0[4], s[5] * inv - c0[5]); o.w = cvt_pk_bf16(s[6] * inv - c0[6], s[7] * inv - c0[7]);
        *(u32x4*)(pooled + (size_t)tok * 512 + cc * 8) = o;
    }
}

__device__ __forceinline__ void scan_phase(Frame& F, const Args& a, int l, const float* E, bf16_t* uc) {
    LAS float* ser = (LAS float*)F.lds;
    LAS float* sei = ser + 512;
    for (int bg = blockIdx.x; bg < NB * NG; bg += F.G) {
        const int b = bg / NG, g = bg % NG, p = F.tid & 63, seg = F.tid >> 6;
        __syncthreads();
        const float dt = __expf(a.in[7][l * NG + g]); const float ar = a.in[5][(size_t)(l * NG + g) * NP + p], ai = a.in[6][(size_t)(l * NG + g) * NP + p];
        const float mag = expf(ar * dt), ang = ai * dt; float lr = mag * cosf(ang), li = mag * sinf(ang);
#pragma unroll
        for (int q = 0; q < 4; ++q) { const float nr = lr * lr - li * li, ni = 2.f * lr * li; lr = nr; li = ni; }
        float er[32], ei[32];
        const float* Ep = E + ((size_t)g * CROWS + (size_t)b * NCH + seg * 32) * 128 + p;
#pragma unroll
        for (int j = 0; j < 32; ++j) { er[j] = Ep[(size_t)j * 128]; ei[j] = Ep[(size_t)j * 128 + 64]; }
        float hr = 0.f, hi = 0.f;
#pragma unroll
        for (int j = 0; j < 32; ++j) { const float nr = lr * hr - li * hi + er[j], ni = lr * hi + li * hr + ei[j]; hr = nr; hi = ni; }
        ser[seg * 64 + p] = hr; sei[seg * 64 + p] = hi;
        float Lr = lr, Li = li;
#pragma unroll
        for (int q = 0; q < 5; ++q) { const float nr = Lr * Lr - Li * Li, ni = 2.f * Lr * Li; Lr = nr; Li = ni; }
        __syncthreads();
        hr = 0.f; hi = 0.f;
        for (int s = 0; s < seg; ++s) { const float nr = Lr * hr - Li * hi + ser[s * 64 + p], ni = Lr * hi + Li * hr + sei[s * 64 + p]; hr = nr; hi = ni; }
        bf16_t* up = uc + ((size_t)g * CROWS + (size_t)b * NCH + seg * 32) * UCLD + 256 + p;
#pragma unroll
        for (int j = 0; j < 32; ++j) { up[(size_t)j * UCLD] = (bf16_t)(cvt_pk_bf16(hr, 0.f) & 0xffffu); up[(size_t)j * UCLD + 64] = (bf16_t)(cvt_pk_bf16(hi, 0.f) & 0xffffu);
            const float nr = lr * hr - li * hi + er[j], ni = lr * hi + li * hr + ei[j]; hr = nr; hi = ni; }
    }
}

#ifndef MK_ONLY
#define MK_ONLY -1
#endif
__global__ void __launch_bounds__(NWAVES * 64, 2) fwd_kernel(Args args) {
    extern __shared__ __attribute__((aligned(16))) unsigned char lds_raw[];
    Frame F;
    F.lds = (LAS unsigned char*)lds_raw;
    F.MISC = (volatile LAS unsigned*)(F.lds + MISC_OFF);
    F.G = gridDim.x; F.NGW = F.G * NWAVES; F.tid = 0; F.lane = 0; F.wave = 0; F.gw = 0;
    if (threadIdx.x < 32) F.MISC[threadIdx.x] = 0u;
    __syncthreads();
    XcdBarrier bar = xcd_barrier_post((unsigned*)(args.ws + WS_CTL) + CW_BAR, F.MISC + 8);
    const int lo = args.ph_lo, hi = args.ph_hi; int gp = 0;
    LAS unsigned char* ring = F.lds; LAS unsigned char* xl = F.lds + XL_OFF;
    const int c0_ = (int)blockIdx.x, G0_ = (int)gridDim.x;
    const int vc0_ = (G0_ % 8 == 0) ? (c0_ % 8) * (G0_ / 8) + c0_ / 8 : c0_;
#define PHASE_BEGIN(id) if ((MK_ONLY < 0 || MK_ONLY == (id)) && gp >= lo && gp < hi) { \
        GU8* wsp1 = (GU8*)args.ws; GF32* outp1 = (GF32*)args.out; int c = c0_, vc = vc0_, G = G0_; asm volatile("" : "+s"(wsp1), "+s"(outp1), "+s"(c), "+s"(vc), "+s"(G)); int t_ = threadIdx.x; asm volatile("" : "+v"(t_)); \
        unsigned char* wsp = (unsigned char*)wsp1; float* outp = (float*)outp1; \
        F.ws = wsp; F.ctl = (unsigned*)(wsp + WS_CTL); F.x = outp; F.xb = (bf16_t*)(wsp + WS_XB); F.tid = t_; F.lane = t_ & 63; F.wave = __builtin_amdgcn_readfirstlane(t_ >> 6); F.G = G; F.NGW = G * NWAVES; F.gw = c * NWAVES + F.wave; \
        unsigned char* const wl = wsp + WS_WL; unsigned char* const act = wsp + WS_ACT; unsigned char* const fw = wsp + WS_FFW; unsigned char* const kv = wsp + WS_KV; (void)wl; (void)act; (void)fw; (void)kv;
#define PHASE_END if (gp + 1 < hi) xcd_barrier(bar); } ++gp;
#define BF(p) ((bf16_t*)(p))
#define CBF(p) ((const bf16_t*)(p))

    PHASE_BEGIN(0) init_phase(F, args); PHASE_END
    PHASE_BEGIN(1) { pg8::SchedKv S{CBF(kv + KV_WKV), CBF(kv + KV_MEMB), D, D, D, G, c}; pg8::EpiKv E{BF(kv + KV_MATS)}; pg8::gemm_phase(ring, xl, S, E); } PHASE_END

#pragma unroll 1
    for (int l = 0; l < DEPTH; ++l) {
        PHASE_BEGIN(2) prep_phase(F, args, l); PHASE_END
        PHASE_BEGIN(3) { pg8::SchedPlain S{F.xb, CBF(wl + WL_WIN), D, D, D, T / 256, INC / 256, G, c}; pg8::EpiProj E{BF(act + A_UC), BF(act + A_UPOOL), BF(act + A_GATES)}; pg8::gemm_phase(ring, xl, S, E); } PHASE_END
        PHASE_BEGIN(4) { pg8::SchedSsm S{CBF(act + A_UC), CBF(wl + WL_BT1), UCLD, 256, 256, G, vc}; pg8::EpiSsmE E{(float*)(act + A_EBUF)}; pg8::gemm_phase(ring, xl, S, E);
                         pool_phase(F, CBF(act + A_UPOOL), BF(act + A_POOLED)); } PHASE_END
        PHASE_BEGIN(5) scan_phase(F, args, l, (const float*)(act + A_EBUF), BF(act + A_UC)); PHASE_END
        PHASE_BEGIN(6) { pg8::SchedSsm S{CBF(act + A_UC), CBF(wl + WL_BT2), UCLD, UCLD, UCLD, G, vc}; pg8::EpiSsmY E{CBF(act + A_UC), args.in[12] + (size_t)l * SSMW, BF(act + A_YSG)}; pg8::gemm_phase(ring, xl, S, E); }
                       { pg8::SchedPlain S{CBF(act + A_POOLED), CBF(wl + WL_WPBD), 512, 512, 512, T / 256, 2, G, c}; pg8::EpiBf16 E{BF(act + A_POOLOUT), 512, 1.0f, 0}; pg8::gemm_phase(ring, xl, S, E); } PHASE_END
        PHASE_BEGIN(7) { pg8::SchedPlain S{CBF(act + A_YSG), CBF(wl + WL_WGLU), 512, 512, 512, T / 256, 2, G, c}; pg8::EpiGlu E{CBF(act + A_YSG), args.in[14] + (size_t)l * SSMW, BF(act + A_SSMOUT)}; pg8::gemm_phase(ring, xl, S, E); } PHASE_END
        PHASE_BEGIN(8) { pg8::SchedPlain S{CBF(act + A_SSMOUT), CBF(wl + WL_WSUP), 512, 512, 512, T / 256, 4, G, c}; pg8::EpiUp<false> E{CBF(act + A_GATES), BF(act + A_INNER)}; pg8::gemm_phase(ring, xl, S, E); }
                       { pg8::SchedPlain S{CBF(act + A_POOLOUT), CBF(wl + WL_WPUP), 512, 512, 512, T / 256, 4, G, c}; pg8::EpiUp<true> E{CBF(act + A_GATES) + 1024, BF(act + A_INNER)}; pg8::gemm_phase(ring, xl, S, E); } PHASE_END
        PHASE_BEGIN(9) { pg8::SchedPlain S{CBF(act + A_INNER), CBF(wl + WL_WOUT), D, D, D, T / 256, 4, G, c}; pg8::EpiRes E{F.x}; pg8::gemm_phase(ring, xl, S, E); } PHASE_END
        PHASE_BEGIN(10) ln_phase<0>(F, args.in[2] + (size_t)l * D, args.in[3] + (size_t)l * D, nullptr, nullptr, nullptr, nullptr); PHASE_END
        PHASE_BEGIN(11) { pg8::SchedPlain S{F.xb, CBF(wl + WL_WQ), D, D, D, T / 256, 4, G, c}; pg8::EpiBf16 E{BF(act + A_Q), D, 0.0625f, 0}; pg8::gemm_phase(ring, xl, S, E); } PHASE_END
        PHASE_BEGIN(12) { pg8::SchedAttn S{CBF(act + A_Q), CBF(kv + KV_MATS) + (size_t)l * (2 * MROWS * D), D, D, HD, G, vc, 0}; pg8::EpiSoftmax E{BF(act + A_P)}; pg8::gemm_phase(ring, xl, S, E); } PHASE_END
        PHASE_BEGIN(13) { pg8::SchedAttn S{CBF(act + A_P), CBF(kv + KV_MATS) + (size_t)l * (2 * MROWS * D) + (size_t)MROWS * D, D, MROWS, NMEM, G, vc, 1}; pg8::EpiBf16 E{BF(act + A_AO), D, 1.0f, 0}; pg8::gemm_phase(ring, xl, S, E); } PHASE_END
        PHASE_BEGIN(14) { pg8::SchedPlain S{CBF(act + A_AO), CBF(wl + WL_WO), D, D, D, T / 256, 4, G, c}; pg8::EpiRes E{F.x}; pg8::gemm_phase(ring, xl, S, E); } PHASE_END
        if ((l & 1) == 0) {
            PHASE_BEGIN(15) ln_phase<0>(F, args.in[20] + (size_t)l * D, args.in[21] + (size_t)l * D, nullptr, nullptr, nullptr, nullptr); PHASE_END
            PHASE_BEGIN(16) { pg8::SchedPlain S{F.xb, CBF(fw + FW_W13), D, D, D, T / 256, 2 * FFD / 256, G, c}; pg8::EpiSwiglu E{BF(act + A_H), FFD}; pg8::gemm_phase(ring, xl, S, E); } PHASE_END
            PHASE_BEGIN(17) { pg8::SchedPlain S{CBF(act + A_H), CBF(fw + FW_W2), FFD, FFD, FFD, T / 256, 4, G, c}; pg8::EpiRes E{F.x}; pg8::gemm_phase(ring, xl, S, E); } PHASE_END
            PHASE_BEGIN(18) ln_phase<0>(F, args.in[26] + (size_t)l * D, args.in[27] + (size_t)l * D, nullptr, nullptr, nullptr, nullptr); PHASE_END
        } else {
            PHASE_BEGIN(19) ln_phase<1>(F, args.in[20] + (size_t)l * D, args.in[21] + (size_t)l * D, args.in[31] + (size_t)(l >> 1) * D * NE, (uint4*)(act + A_TOKINFO), nullptr, nullptr); PHASE_END
            PHASE_BEGIN(20) moe_gather_phase(F, (const uint4*)(act + A_TOKINFO), (uint2*)(act + A_TOKPOS), BF(act + A_XS)); PHASE_END
            PHASE_BEGIN(21) { const int ntl = (int)F.ctl[CW_META]; pg8::SchedMoe S{CBF(act + A_XS), CBF(fw + FW_W13), F.ctl + CW_META, D, D, D, ntl, 2 * FFE / 256, G, c}; pg8::EpiSwiglu E{BF(act + A_HM), FFE}; pg8::gemm_phase(ring, xl, S, E); } PHASE_END
            PHASE_BEGIN(22) { const int ntl = (int)F.ctl[CW_META]; pg8::SchedMoe S{CBF(act + A_HM), CBF(fw + FW_W2), F.ctl + CW_META, FFE, FFE, FFE, ntl, 4, G, c}; pg8::EpiBf16 E{BF(act + A_Y), D, 1.0f, 0}; pg8::gemm_phase(ring, xl, S, E); } PHASE_END
            PHASE_BEGIN(23) ln_phase<2>(F, args.in[26] + (size_t)l * D, args.in[27] + (size_t)l * D, nullptr, (uint4*)(act + A_TOKINFO), (const uint2*)(act + A_TOKPOS), CBF(act + A_Y)); PHASE_END
        }
    }
#undef PHASE_BEGIN
#undef PHASE_END
}
constexpr int N_PHASES = 2 + 2 * (13 + 4) + 2 * (13 + 5);


#ifndef MK_DUMP_OFF
#define MK_DUMP_OFF (WS_WL + WL_WSUP)
#define MK_DUMP_OFF2 (WS_ACT + A_GATES)
#endif
#ifndef MK_DUMP_KIND
#define MK_DUMP_KIND 0
#endif
#ifndef MK_DUMP_N
#define MK_DUMP_N (0)
#endif
__global__ void dump_kernel(const unsigned char* ws, float* out) {
    for (size_t i = (size_t)blockIdx.x * blockDim.x + threadIdx.x; i < (size_t)T * D; i += (size_t)gridDim.x * blockDim.x) {
        float v = 0.f;
        if (i < (size_t)MK_DUMP_N) { if (MK_DUMP_KIND == 1) v = __uint_as_float((unsigned)((const bf16_t*)(ws + MK_DUMP_OFF))[i] << 16); else v = ((const float*)(ws + MK_DUMP_OFF))[i]; }
        else if (MK_DUMP_KIND == 1) v = __uint_as_float((unsigned)((const bf16_t*)(ws + MK_DUMP_OFF2))[i - MK_DUMP_N] << 16);
        out[i] = v; }
}
extern "C" void kernel_launch(void* const* d_in, const int* in_sizes, int n_in, void* d_out, int out_size, void* d_ws, size_t ws_size, hipStream_t stream) {
    static int grid = 0;
    if (grid == 0) {
        if (n_in != 35 || in_sizes[0] != T * D || out_size != T * D || ws_size < WS_END) { fprintf(stderr, "kernel_launch: unexpected problem (n_in %d, in0 %d, out %d, ws %zu, need %zu); nothing launched\n", n_in, n_in > 0 ? in_sizes[0] : -1, out_size, ws_size, (size_t)WS_END); grid = -1; return; }
        int dev = 0, cus = 0, per_cu = 0;
        if (hipGetDevice(&dev) != hipSuccess || hipDeviceGetAttribute(&cus, hipDeviceAttributeMultiprocessorCount, dev) != hipSuccess) { grid = -1; return; }
        if (hipFuncSetAttribute((const void*)fwd_kernel, hipFuncAttributeMaxDynamicSharedMemorySize, LDS_BYTES) != hipSuccess) { fprintf(stderr, "kernel_launch: hipFuncSetAttribute failed\n"); grid = -1; return; }
        if (hipOccupancyMaxActiveBlocksPerMultiprocessor(&per_cu, (const void*)fwd_kernel, NWAVES * 64, LDS_BYTES) != hipSuccess || per_cu < 1) fprintf(stderr, "kernel_launch: occupancy query reports %d\n", per_cu);
        (void)hipGetLastError();
        grid = cus;
    }
    if (grid < 0) return;
    if (hipMemsetAsync((char*)d_ws + WS_CTL, 0, CTL_ZERO_BYTES, stream) != hipSuccess) return;
    Args a{};
    for (int i = 0; i < 35; ++i) a.in[i] = (const float*)d_in[i];
    a.out = (float*)d_out; a.ws = (unsigned char*)d_ws;
#if MK_PER_PHASE
    for (int p = 0; p < (MK_PMAX < N_PHASES ? MK_PMAX : N_PHASES); ++p) { a.ph_lo = p; a.ph_hi = p + 1; hipLaunchKernelGGL(fwd_kernel, dim3(grid), dim3(NWAVES * 64), LDS_BYTES, stream, a); }
    if (MK_DUMP_KIND) hipLaunchKernelGGL(dump_kernel, dim3(2048), dim3(256), 0, stream, (const unsigned char*)d_ws, (float*)d_out);
#else
    a.ph_lo = 0; a.ph_hi = N_PHASES;
    hipLaunchKernelGGL(fwd_kernel, dim3(grid), dim3(NWAVES * 64), LDS_BYTES, stream, a);
#endif
}
```
